# Optimizing an MI355X kernel written in HIP

```python
import math
import jax, jax.numpy as jnp
from jax import lax
import numpy as np

D_MODEL = 1024
BATCH = 2
SEQ = 16384
DEPTH = 2

N_MIXERS = 2
N_FOX_LAYERS = (DEPTH + N_MIXERS - 1) // N_MIXERS
N_NSA_LAYERS = DEPTH // N_MIXERS
HEAD_DIM = 64
FOX_HEADS = D_MODEL // HEAD_DIM
NSA_HEADS = D_MODEL // HEAD_DIM
NSA_KV_GROUPS = 4
NSA_HPG = NSA_HEADS // NSA_KV_GROUPS
CMP_LEN = 32
CMP_STRIDE = 16
CMP_HIDDEN = 2 * HEAD_DIM
SEL_BLOCK = 64
SEL_TOPK = 16
WINDOW = 512
Q_BLOCK = 128
REL_BUCKETS = 32
REL_MAX_DIST = 128
FF_HIDDEN = -(-8 * D_MODEL // (3 * 256)) * 256
DN_ALPHA = (2 * DEPTH) ** 0.25
DN_BETA = (8 * DEPTH) ** -0.25
LN_EPS = 1e-5
NEG = -1e30
FORCE = 1e9
TINY = 1e-30

kernel_name = 'fox_nsa_hybrid_deepnorm_adaln'


def layer_norm(x, g, b):
    xf = x.astype(jnp.float32)
    mu = xf.mean(-1, keepdims=True)
    var = jnp.square(xf - mu).mean(-1, keepdims=True)
    return ((xf - mu) * lax.rsqrt(var + LN_EPS) * g + b).astype(x.dtype)


def t5_bucket(dist):
    max_exact = REL_BUCKETS // 2
    d = jnp.maximum(dist, 0)
    large = max_exact + (jnp.log(jnp.maximum(d, 1).astype(jnp.float32) / max_exact)
                         / math.log(REL_MAX_DIST / max_exact) * (REL_BUCKETS - max_exact)).astype(jnp.int32)
    large = jnp.minimum(large, REL_BUCKETS - 1)
    return jnp.where(d < max_exact, d, large)


def masked_softmax(s, valid):
    s = jnp.where(valid, s, NEG)
    p = jnp.exp(s - s.max(-1, keepdims=True)) * valid
    return p / jnp.maximum(p.sum(-1, keepdims=True), TINY)


def fox_attention(h, w_in, b_f, w_out):
    B, S, _ = h.shape
    H, DH = FOX_HEADS, HEAD_DIM
    proj = jnp.einsum('bsd,de->bse', h, w_in)
    q, k, v, f_logit = jnp.split(proj, [D_MODEL, 2 * D_MODEL, 3 * D_MODEL], axis=-1)
    heads = lambda t: t.reshape(B, S, H, DH).transpose(0, 2, 1, 3)
    q = heads(q) * (DH ** -0.5)
    k = heads(k)
    v = heads(v)
    cum_logf = jnp.cumsum(jax.nn.log_sigmoid((f_logit + b_f).astype(jnp.float32)), axis=1).transpose(0, 2, 1)
    ar = jnp.arange(Q_BLOCK)

    def q_block(i):
        t0 = i * Q_BLOCK
        qi = lax.dynamic_slice_in_dim(q, t0, Q_BLOCK, axis=2)
        Fi = lax.dynamic_slice_in_dim(cum_logf, t0, Q_BLOCK, axis=2)

        def kv_step(j, carry):
            m, l, acc = carry
            s0 = j * Q_BLOCK
            kj = lax.dynamic_slice_in_dim(k, s0, Q_BLOCK, axis=2)
            vj = lax.dynamic_slice_in_dim(v, s0, Q_BLOCK, axis=2)
            Fj = lax.dynamic_slice_in_dim(cum_logf, s0, Q_BLOCK, axis=2)
            s = jnp.einsum('bhqd,bhkd->bhqk', qi, kj, preferred_element_type=jnp.float32) \
                + (Fi[..., :, None] - Fj[..., None, :])
            s = jnp.where((t0 + ar)[:, None] >= (s0 + ar)[None, :], s, NEG)
            m_new = jnp.maximum(m, s.max(-1))
            p = jnp.exp(s - m_new[..., None])
            corr = jnp.exp(m - m_new)
            acc = acc * corr[..., None] + jnp.einsum('bhqk,bhkd->bhqd', p, vj, preferred_element_type=jnp.float32)
            return (m_new, l * corr + p.sum(-1), acc)

        init = (jnp.full((B, H, Q_BLOCK), NEG, jnp.float32),
                jnp.zeros((B, H, Q_BLOCK), jnp.float32),
                jnp.zeros((B, H, Q_BLOCK, DH), jnp.float32))
        m, l, acc = lax.fori_loop(0, i + 1, kv_step, init)
        return acc / l[..., None]

    out = lax.map(q_block, jnp.arange(S // Q_BLOCK))
    out = out.transpose(1, 0, 3, 2, 4).reshape(B, S, D_MODEL).astype(h.dtype)
    return out @ w_out


def nsa_attention(h, w_in, b_gate, cmp_pos, cmp_w1, cmp_w2, w_out, rel_bias):
    B, S, _ = h.shape
    G, HPG, DH = NSA_KV_GROUPS, NSA_HPG, HEAD_DIM
    KVW = G * DH
    n_cmp = (S - CMP_LEN) // CMP_STRIDE + 1
    n_sel = S // SEL_BLOCK
    k_top = min(SEL_TOPK, n_sel)
    R = SEL_BLOCK // CMP_STRIDE
    O = CMP_LEN // CMP_STRIDE - 1

    proj = jnp.einsum('bsd,de->bse', h, w_in)
    cuts = [D_MODEL + n * KVW for n in range(7)]
    q, k_c, v_c, k_s, v_s, k_w, v_w, g_logit = jnp.split(proj, cuts, axis=-1)
    q = q.reshape(B, S, G, HPG, DH).transpose(0, 2, 3, 1, 4) * (DH ** -0.5)
    heads = lambda t: t.reshape(B, S, G, DH).transpose(0, 2, 1, 3)
    k_c, v_c, k_s, v_s, k_w, v_w = [heads(t) for t in (k_c, v_c, k_s, v_s, k_w, v_w)]
    gates = jax.nn.sigmoid((g_logit + b_gate).astype(jnp.float32)).reshape(B, S, 3, G, HPG).transpose(2, 0, 3, 4, 1)

    blk_idx = jnp.arange(n_cmp)[:, None] * CMP_STRIDE + jnp.arange(CMP_LEN)[None, :]

    def compress(t, pos, w1, w2):
        blocks = (t[:, :, blk_idx] + pos).reshape(B, G, n_cmp, CMP_LEN * DH)
        return jax.nn.silu(blocks @ w1) @ w2

    k_cmp = compress(k_c, cmp_pos[0], cmp_w1[0], cmp_w2[0])
    v_cmp = compress(v_c, cmp_pos[1], cmp_w1[1], cmp_w2[1])
    cmp_end = jnp.arange(n_cmp) * CMP_STRIDE + CMP_LEN - 1

    k_sb = k_s.reshape(B, G, n_sel, SEL_BLOCK, DH)
    v_sb = v_s.reshape(B, G, n_sel, SEL_BLOCK, DH)
    k_wp = jnp.pad(k_w, ((0, 0), (0, 0), (WINDOW, 0), (0, 0)))
    v_wp = jnp.pad(v_w, ((0, 0), (0, 0), (WINDOW, 0), (0, 0)))

    rb_group = rel_bias.reshape(REL_BUCKETS, G, HPG).transpose(1, 0, 2)
    b_ix = jnp.arange(B)[:, None, None, None]
    g_ix = jnp.arange(G)[None, :, None, None]
    blk = jnp.arange(n_sel)

    def head_bias(dist):
        return rel_bias[t5_bucket(dist)].transpose(2, 0, 1).reshape(G, HPG, *dist.shape)

    def q_block(i):
        t0 = i * Q_BLOCK
        qi = lax.dynamic_slice_in_dim(q, t0, Q_BLOCK, axis=3)
        tpos = t0 + jnp.arange(Q_BLOCK)

        dist_c = tpos[:, None] - cmp_end[None, :]
        s_c = jnp.einsum('bghqd,bgnd->bghqn', qi, k_cmp, preferred_element_type=jnp.float32) + head_bias(dist_c)
        p_c = masked_softmax(s_c, dist_c >= 0)
        o_c = jnp.einsum('bghqn,bgnd->bghqd', p_c, v_cmp, preferred_element_type=jnp.float32)

        imp = jnp.pad(p_c.sum(2), ((0, 0), (0, 0), (0, 0), (O, max(R * n_sel - n_cmp, 0))))
        imp_sel = sum(imp[..., a:a + R * n_sel:R] for a in range(R + O))
        cur = tpos // SEL_BLOCK
        forced = (blk[None, :] == 0) | (blk[None, :] == cur[:, None]) | (blk[None, :] == cur[:, None] - 1)
        score = jnp.where(forced, FORCE, jnp.where(blk[None, :] <= cur[:, None], imp_sel, NEG))
        top_s, top_i = lax.top_k(score, k_top)

        ksel = k_sb[b_ix, g_ix, top_i]
        vsel = v_sb[b_ix, g_ix, top_i]
        spos = top_i[..., None] * SEL_BLOCK + jnp.arange(SEL_BLOCK)
        dist_s = tpos[:, None, None] - spos
        valid_s = (dist_s >= 0) & (top_s[..., None] > 0.5 * NEG)
        bias_s = rb_group[g_ix[..., None], t5_bucket(dist_s)].transpose(0, 1, 5, 2, 3, 4)
        s_s = jnp.einsum('bghqd,bgqkcd->bghqkc', qi, ksel, preferred_element_type=jnp.float32) + bias_s
        shp = s_s.shape
        p_s = masked_softmax(s_s.reshape(B, G, HPG, Q_BLOCK, -1), valid_s.reshape(B, G, 1, Q_BLOCK, -1))
        o_s = jnp.einsum('bghqkc,bgqkcd->bghqd', p_s.reshape(shp), vsel, preferred_element_type=jnp.float32)

        kw = lax.dynamic_slice_in_dim(k_wp, t0, Q_BLOCK + WINDOW, axis=2)
        vw = lax.dynamic_slice_in_dim(v_wp, t0, Q_BLOCK + WINDOW, axis=2)
        spos_w = t0 - WINDOW + jnp.arange(Q_BLOCK + WINDOW)
        dist_w = tpos[:, None] - spos_w[None, :]
        valid_w = (dist_w >= 0) & (dist_w < WINDOW) & (spos_w[None, :] >= 0)
        s_w = jnp.einsum('bghqd,bgkd->bghqk', qi, kw, preferred_element_type=jnp.float32) + head_bias(dist_w)
        p_w = masked_softmax(s_w, valid_w)
        o_w = jnp.einsum('bghqk,bgkd->bghqd', p_w, vw, preferred_element_type=jnp.float32)

        g = lax.dynamic_slice_in_dim(gates, t0, Q_BLOCK, axis=4)[..., None]
        return g[0] * o_c + g[1] * o_s + g[2] * o_w

    out = lax.map(q_block, jnp.arange(S // Q_BLOCK))
    out = out.transpose(1, 0, 4, 2, 3, 5).reshape(B, S, D_MODEL).astype(h.dtype)
    return out @ w_out


def swiglu(h, w_in, w_out):
    a, b = jnp.split(h @ w_in, 2, axis=-1)
    return (jax.nn.silu(a) * b) @ w_out


def setup_inputs(seed: int = 0) -> dict:
    key = jax.random.key(seed)
    ks = jax.random.split(key, 20)
    D = D_MODEL
    f32 = jnp.float32
    nrm = lambda k, shape, scale: scale * jax.random.normal(k, shape, f32)
    kvw = NSA_KV_GROUPS * HEAD_DIM
    fox_cols = 3 * D + FOX_HEADS
    fox_colscale = jnp.concatenate([jnp.ones(2 * D, f32), jnp.full((D,), DN_BETA, f32), jnp.full((FOX_HEADS,), 0.5, f32)])
    nsa_cols = D + 6 * kvw + 3 * NSA_HEADS
    beta_v = jnp.full((kvw,), DN_BETA, f32)
    nsa_colscale = jnp.concatenate([jnp.ones(D + kvw, f32), beta_v, jnp.ones(kvw, f32), beta_v,
                                    jnp.ones(kvw, f32), beta_v, jnp.ones(3 * NSA_HEADS, f32)])
    return {
        'x': nrm(ks[0], (BATCH, SEQ, D), 1.0),
        'c': nrm(ks[1], (BATCH, D), 1.0),
        'ada_w': nrm(ks[2], (DEPTH, D, 6 * D), 0.2 * D ** -0.5),
        'ada_b': nrm(ks[3], (DEPTH, 6 * D), 0.02),
        'ln_g': 1.0 + nrm(ks[4], (DEPTH, 2, D), 0.02),
        'ln_b': nrm(ks[5], (DEPTH, 2, D), 0.02),
        'fox_w_in': nrm(ks[6], (N_FOX_LAYERS, D, fox_cols), D ** -0.5) * fox_colscale,
        'fox_b_f': jnp.linspace(1.0, 6.0, FOX_HEADS, dtype=f32)[None, :] + nrm(ks[7], (N_FOX_LAYERS, FOX_HEADS), 0.1),
        'fox_w_out': nrm(ks[8], (N_FOX_LAYERS, D, D), DN_BETA * D ** -0.5),
        'nsa_w_in': nrm(ks[9], (N_NSA_LAYERS, D, nsa_cols), D ** -0.5) * nsa_colscale,
        'nsa_b_gate': nrm(ks[10], (N_NSA_LAYERS, 3 * NSA_HEADS), 0.1),
        'nsa_cmp_pos': nrm(ks[11], (N_NSA_LAYERS, 2, CMP_LEN, HEAD_DIM), 0.1),
        'nsa_cmp_w1': nrm(ks[12], (N_NSA_LAYERS, 2, CMP_LEN * HEAD_DIM, CMP_HIDDEN), (CMP_LEN * HEAD_DIM) ** -0.5),
        'nsa_cmp_w2': nrm(ks[13], (N_NSA_LAYERS, 2, CMP_HIDDEN, HEAD_DIM), CMP_HIDDEN ** -0.5),
        'nsa_w_out': nrm(ks[14], (N_NSA_LAYERS, D, D), DN_BETA * D ** -0.5),
        'rel_bias': nrm(ks[15], (REL_BUCKETS, NSA_HEADS), 0.5),
        'ffn_w_in': nrm(ks[16], (DEPTH, D, 2 * FF_HIDDEN), DN_BETA * D ** -0.5),
        'ffn_w_out': nrm(ks[17], (DEPTH, FF_HIDDEN, D), DN_BETA * FF_HIDDEN ** -0.5),
    }


def reference(x, c, ada_w, ada_b, ln_g, ln_b, fox_w_in, fox_b_f, fox_w_out,
              nsa_w_in, nsa_b_gate, nsa_cmp_pos, nsa_cmp_w1, nsa_cmp_w2, nsa_w_out,
              rel_bias, ffn_w_in, ffn_w_out):
    cs = jax.nn.silu(c)
    for i in range(DEPTH):
        mod = cs @ ada_w[i] + ada_b[i]
        sh_a, sc_a, g_a, sh_f, sc_f, g_f = jnp.split(mod, 6, axis=-1)
        h = x * (1.0 + sc_a[:, None]) + sh_a[:, None]
        j = i // N_MIXERS
        if i % N_MIXERS == 0:
            y = fox_attention(h, fox_w_in[j], fox_b_f[j], fox_w_out[j])
        else:
            y = nsa_attention(h, nsa_w_in[j], nsa_b_gate[j], nsa_cmp_pos[j], nsa_cmp_w1[j],
                              nsa_cmp_w2[j], nsa_w_out[j], rel_bias)
        x = layer_norm(DN_ALPHA * x + (1.0 + g_a[:, None]) * y, ln_g[i, 0], ln_b[i, 0])
        h = x * (1.0 + sc_f[:, None]) + sh_f[:, None]
        y = swiglu(h, ffn_w_in[i], ffn_w_out[i])
        x = layer_norm(DN_ALPHA * x + (1.0 + g_f[:, None]) * y, ln_g[i, 1], ln_b[i, 1])
    return x
```

```cpp
#include <hip/hip_runtime.h>
#include <hip/hip_bf16.h>
#include <cstdio>
#include <cstdint>
#include <cmath>
namespace pg8 {
#define PG8_LAS __attribute__((address_space(3)))
typedef unsigned short bf16_t;
typedef short bf16x8 __attribute__((ext_vector_type(8)));
typedef float f32x4 __attribute__((ext_vector_type(4)));
typedef unsigned u32x4 __attribute__((ext_vector_type(4)));
constexpr int BM = 256, BK = 64, HALF = 128, HTB = HALF * BK * 2  , STAGE_BYTES = 8 * HTB, NXCD = 8, WGM = 8;

__host__ __device__ __forceinline__ int lds_byte(int r, int c) { const int st = (r >> 4) * 2 + (c >> 5), rr = r & 15, cc = c & 31, ob = rr * 64 + cc * 2; return st * 1024 + (ob ^ (((ob >> 9) & 1) << 5)); }
__host__ __device__ __forceinline__ void stage_rc(int b, int& R, int& C) { const int st = b / 1024, sb = b % 1024, swz = sb ^ (((sb >> 9) & 1) << 5); R = (st >> 1) * 16 + swz / 64; C = (st & 1) * 32 + (swz % 64) / 2; }
__host__ __device__ __forceinline__ int perm32(int rho) { const int n = rho >> 4, i = rho & 15; return 8 * (i >> 2) + 4 * n + (i & 3); }

struct Unit { int pm, pn; };
struct Gemm { const bf16_t* A; const bf16_t* Bt; int M, N, K; };

struct StaticOrder {
    int nM, nN, nwg, G, c;
    __host__ __device__ void init(int M, int N, int G_, int c_) { nM = M / BM; nN = N / BM; nwg = nM * nN; G = G_; c = c_; }
    __host__ __device__ bool next(int i, Unit& u) const {
        const long L = (long)i * G + c; if (L >= nwg) return false;
        int wgid = (int)L; { const int q = nwg / NXCD, r = nwg % NXCD, xcd = wgid % NXCD, off = wgid / NXCD; wgid = (xcd < r ? xcd * (q + 1) : r * (q + 1) + (xcd - r) * q) + off; }
        const int nig = WGM * nN, gid = wgid / nig, fm = gid * WGM, gsz = (nM - fm) < WGM ? (nM - fm) : WGM;
        u.pm = fm + ((wgid % nig) % gsz); u.pn = (wgid % nig) / gsz; return true;
    }
    __device__ __forceinline__ void a_ready(const Unit&) const {}
    __device__ __forceinline__ void done(const Unit&) const {}
};

__device__ __forceinline__ unsigned cvt_pk_bf16(float lo, float hi) { unsigned r; asm volatile("v_cvt_pk_bf16_f32 %0, %1, %2" : "=v"(r) : "v"(lo), "v"(hi)); return r; }
typedef float f32x2 __attribute__((ext_vector_type(2)));
typedef float f32x2 __attribute__((ext_vector_type(2)));
constexpr float QSCALE = 0.125f * 1.4426950408889634f;
__device__ __forceinline__ u32x4 pack8(f32x4 v0, f32x4 v1) { u32x4 w; w.x = cvt_pk_bf16(v0[0], v0[1]); w.y = cvt_pk_bf16(v0[2], v0[3]); w.z = cvt_pk_bf16(v1[0], v1[1]); w.w = cvt_pk_bf16(v1[2], v1[3]); return w; }
struct EpiFoxIn {
    static constexpr bool PERM = true, AFTER_DRAIN = false;
    bf16_t* Q; size_t qkv_stride; float* flogit;
    __device__ __forceinline__ void operator()(const f32x4 (&acc)[2][2][4][2], const Unit& u, int wr, int wc, int fr, int fq) const {
        const int row0 = u.pm * BM + wr * 64 + fr;
        if (u.pn < 12) {
            const int t = u.pn >> 2; bf16_t* base = Q + (size_t)t * qkv_stride; const float sc = t == 0 ? QSCALE : 1.f;
            const int col0 = (u.pn & 3) * BM + wc * 32 + 8 * fq;
#pragma unroll
            for (int ai = 0; ai < 2; ++ai)
#pragma unroll
                for (int m = 0; m < 4; ++m) { bf16_t* rowp = base + (size_t)(row0 + ai * HALF + m * 16) * 1024 + col0;
#pragma unroll
                    for (int bj = 0; bj < 2; ++bj) *(u32x4*)(rowp + bj * HALF) = pack8(acc[ai][bj][m][0] * sc, acc[ai][bj][m][1] * sc); }
        } else if (wc == 0 && fq < 2) {
#pragma unroll
            for (int ai = 0; ai < 2; ++ai)
#pragma unroll
                for (int m = 0; m < 4; ++m) { float* rowp = flogit + (size_t)(row0 + ai * HALF + m * 16) * 16 + 8 * fq;
                    *(f32x4*)(rowp) = acc[ai][0][m][0]; *(f32x4*)(rowp + 4) = acc[ai][0][m][1]; }
        }
    }
};
struct EpiNsaIn {
    static constexpr bool PERM = true, AFTER_DRAIN = false;
    bf16_t* Q; bf16_t* KV; size_t kv_stride; float* gates; const float* bgate;
    __device__ __forceinline__ void operator()(const f32x4 (&acc)[2][2][4][2], const Unit& u, int wr, int wc, int fr, int fq) const {
        const int row0 = u.pm * BM + wr * 64 + fr;
        if (u.pn < 4) {
            const int col0 = u.pn * BM + wc * 32 + 8 * fq;
#pragma unroll
            for (int ai = 0; ai < 2; ++ai)
#pragma unroll
                for (int m = 0; m < 4; ++m) { bf16_t* rowp = Q + (size_t)(row0 + ai * HALF + m * 16) * 1024 + col0;
#pragma unroll
                    for (int bj = 0; bj < 2; ++bj) *(u32x4*)(rowp + bj * HALF) = pack8(acc[ai][bj][m][0] * QSCALE, acc[ai][bj][m][1] * QSCALE); }
        } else if (u.pn < 10) {
            bf16_t* base = KV + (size_t)(u.pn - 4) * kv_stride; const int col0 = wc * 32 + 8 * fq;
#pragma unroll
            for (int ai = 0; ai < 2; ++ai)
#pragma unroll
                for (int m = 0; m < 4; ++m) { bf16_t* rowp = base + (size_t)(row0 + ai * HALF + m * 16) * 256 + col0;
#pragma unroll
                    for (int bj = 0; bj < 2; ++bj) *(u32x4*)(rowp + bj * HALF) = pack8(acc[ai][bj][m][0], acc[ai][bj][m][1]); }
        } else if (wc == 0 || (wc == 1 && fq < 2)) {
            const int lc = wc * 32 + 8 * fq;
            f32x4 b0 = *(const f32x4*)(bgate + lc), b1 = *(const f32x4*)(bgate + lc + 4);
#pragma unroll
            for (int ai = 0; ai < 2; ++ai)
#pragma unroll
                for (int m = 0; m < 4; ++m) { float* rowp = gates + (size_t)(row0 + ai * HALF + m * 16) * 48 + lc;
                    f32x4 v0 = acc[ai][0][m][0] + b0, v1 = acc[ai][0][m][1] + b1;
#pragma unroll
                    for (int i = 0; i < 4; ++i) { v0[i] = 1.f / (1.f + __expf(-v0[i])); v1[i] = 1.f / (1.f + __expf(-v1[i])); }
                    *(f32x4*)(rowp) = v0; *(f32x4*)(rowp + 4) = v1; }
        }
    }
};
struct EpiSwiGLU {
    static constexpr bool PERM = true, AFTER_DRAIN = false;
    bf16_t* U; int ldu;
    __device__ __forceinline__ void operator()(const f32x4 (&acc)[2][2][4][2], const Unit& u, int wr, int wc, int fr, int fq) const {
        const int row0 = u.pm * BM + wr * 64 + fr; const int col0 = u.pn * HALF + wc * 32 + 8 * fq;
#pragma unroll
        for (int ai = 0; ai < 2; ++ai)
#pragma unroll
            for (int m = 0; m < 4; ++m) { f32x4 r[2];
#pragma unroll
                for (int n = 0; n < 2; ++n) { const f32x4 a = acc[ai][0][m][n], b = acc[ai][1][m][n];
#pragma unroll
                    for (int i = 0; i < 4; ++i) r[n][i] = a[i] * b[i] / (1.f + __expf(-a[i])); }
                *(u32x4*)(U + (size_t)(row0 + ai * HALF + m * 16) * ldu + col0) = pack8(r[0], r[1]); }
    }
};
struct EpiResid {
    static constexpr bool PERM = false, AFTER_DRAIN = false;
    const float* xres; float* z; const float* gate; int gate_bstride; int rows_per_batch; float alpha;
    __device__ __forceinline__ void operator()(const f32x4 (&acc)[2][2][4][2], const Unit& u, int wr, int wc, int fr, int fq) const {
        const int b = (u.pm * BM) / rows_per_batch; const float* g = gate + (size_t)b * gate_bstride;
        const int col0 = u.pn * BM + wc * 32 + 4 * fq;
        f32x4 gv[2][2];
#pragma unroll
        for (int bj = 0; bj < 2; ++bj)
#pragma unroll
            for (int n = 0; n < 2; ++n) gv[bj][n] = *(const f32x4*)(g + col0 + bj * HALF + n * 16) + 1.0f;
#pragma unroll
        for (int ai = 0; ai < 2; ++ai)
#pragma unroll
            for (int m = 0; m < 4; ++m) { const size_t off = (size_t)(u.pm * BM + ai * HALF + wr * 64 + m * 16 + fr) * 1024 + col0;
#pragma unroll
                for (int bj = 0; bj < 2; ++bj)
#pragma unroll
                    for (int n = 0; n < 2; ++n) { const f32x4 xv = *(const f32x4*)(xres + off + bj * HALF + n * 16);
                        *(f32x4*)(z + off + bj * HALF + n * 16) = xv * alpha + gv[bj][n] * acc[ai][bj][m][n]; } }
    }
};
template <class Epi, class Sched, bool ALIGN_EPI = false, bool SP2 = false>
__device__ __forceinline__ void gemm_phase(PG8_LAS unsigned char* lds, const Gemm g, const Sched& S, const Epi& E) {
    const int tid = threadIdx.x, wid = __builtin_amdgcn_readfirstlane(tid >> 6), lane = tid & 63, wr = wid >> 2, wc = wid & 3, fr = lane & 15, fq = lane >> 4;
    const int K = g.K, nt = K / BK;
    unsigned voffA[2], voffB[2];
#pragma unroll
    for (int i = 0; i < 2; ++i) { int R, C; stage_rc(tid * 16 + i * 8192, R, C); const int Rb = Epi::PERM ? ((R & ~31) + perm32(R & 31)) : R;
        voffA[i] = (unsigned)(R * K + C) * 2u; voffB[i] = (unsigned)(Rb * K + C) * 2u; }
    const size_t kstep = (size_t)(BK * 2);
    const size_t hstep = (size_t)HALF * K * 2;
    const size_t tstep = 2 * hstep;
    const unsigned ldsw = (unsigned)wid * 1024u;
    const int aoff = lds_byte(wr * 64 + fr, fq * 8), boff = lds_byte(wc * 32 + fr, fq * 8);
#define PG8_SA(b, h) (((b) * 2 + (h)) * HTB)
#define PG8_SB(b, h) ((4 + (b) * 2 + (h)) * HTB)
#define PG8_STAGE(bufoff, gbase, voff) do { _Pragma("unroll") for (int _i = 0; _i < 2; ++_i) \
        __builtin_amdgcn_global_load_lds((const unsigned*)((const char*)(gbase) + (voff)[_i]), (PG8_LAS unsigned*)(lds + (bufoff) + ldsw + _i * 8192), 16, 0, 0); } while (0)
#define PG8_LDA(dst, b, h) do { _Pragma("unroll") for (int m = 0; m < 4; ++m) _Pragma("unroll") for (int k = 0; k < 2; ++k) dst[m][k] = *(const PG8_LAS bf16x8*)(lds + PG8_SA(b, h) + aoff + m * 2048 + k * 1024); } while (0)
#define PG8_LDB(dst, b, h) do { _Pragma("unroll") for (int n = 0; n < 2; ++n) _Pragma("unroll") for (int k = 0; k < 2; ++k) dst[n][k] = *(const PG8_LAS bf16x8*)(lds + PG8_SB(b, h) + boff + n * 2048 + k * 1024); } while (0)
#define PG8_MMA(ai, bj, At, Bt) do { __builtin_amdgcn_s_setprio(1); _Pragma("unroll") for (int m = 0; m < 4; ++m) _Pragma("unroll") for (int n = 0; n < 2; ++n) _Pragma("unroll") for (int k = 0; k < 2; ++k) \
        acc[ai][bj][m][n] = __builtin_amdgcn_mfma_f32_16x16x32_bf16(Bt[n][k], At[m][k], acc[ai][bj][m][n], 0, 0, 0); __builtin_amdgcn_s_setprio(0); } while (0)
#define PG8_WAIT_V(n) asm volatile("s_waitcnt vmcnt(" #n ")" ::: "memory")
#define PG8_WAIT_L(n) asm volatile("s_waitcnt lgkmcnt(" #n ")" ::: "memory")
#define PG8_BAR __builtin_amdgcn_s_barrier()
#define PG8_SCHED __builtin_amdgcn_sched_barrier(0)
    Unit cur, nxt; int ui = 0;
    if (!S.next(0, cur)) return;
    f32x4 acc[2][2][4][2];
#pragma unroll
    for (int a = 0; a < 2; ++a)
#pragma unroll
        for (int b = 0; b < 2; ++b)
#pragma unroll
            for (int m = 0; m < 4; ++m)
#pragma unroll
                for (int n = 0; n < 2; ++n) acc[a][b][m][n] = (f32x4){0.f, 0.f, 0.f, 0.f};
    bf16x8 At[4][2], B0[2][2], B1[2][2];
    const char* cA = (const char*)g.A + (size_t)cur.pm * tstep; const char* cB = (const char*)g.Bt + (size_t)cur.pn * tstep;
    S.a_ready(cur);
    if constexpr (SP2) {
        PG8_STAGE(PG8_SB(0, 0), cB, voffB); PG8_STAGE(PG8_SB(0, 1), cB + hstep, voffB); PG8_STAGE(PG8_SA(0, 0), cA, voffA); PG8_STAGE(PG8_SA(0, 1), cA + hstep, voffA);
        if (wr == 1) PG8_BAR;
        PG8_WAIT_V(2); PG8_BAR;
        PG8_STAGE(PG8_SB(1, 0), cB + kstep, voffB); PG8_STAGE(PG8_SA(1, 0), cA + kstep, voffA); PG8_STAGE(PG8_SB(1, 1), cB + hstep + kstep, voffB);
        PG8_WAIT_V(6); PG8_BAR;
    } else {
        PG8_STAGE(PG8_SB(0, 0), cB, voffB); PG8_STAGE(PG8_SA(0, 0), cA, voffA); PG8_STAGE(PG8_SB(0, 1), cB + hstep, voffB); PG8_STAGE(PG8_SA(0, 1), cA + hstep, voffA);
        if (wr == 1) PG8_BAR;
        PG8_WAIT_V(4); PG8_BAR;
        PG8_STAGE(PG8_SB(1, 0), cB + kstep, voffB); PG8_STAGE(PG8_SA(1, 0), cA + kstep, voffA); PG8_STAGE(PG8_SB(1, 1), cB + hstep + kstep, voffB);
        PG8_WAIT_V(6); PG8_BAR;
    }
    for (;;) {
        const bool has_next = S.next(ui + 1, nxt);
        const char* nA = has_next ? (const char*)g.A + (size_t)nxt.pm * tstep : cA; const char* nB = has_next ? (const char*)g.Bt + (size_t)nxt.pn * tstep : cB;
        for (int t = 0; t < nt; t += 2) {
            const bool last = (t == nt - 2);
            const char* a1 = cA + (size_t)(t + 1) * kstep;
            const char* a2 = last ? nA : cA + (size_t)(t + 2) * kstep; const char* b2 = last ? nB : cB + (size_t)(t + 2) * kstep;
            const char* a3 = a2 + kstep; const char* b3 = b2 + kstep;
            if (last && has_next) S.a_ready(nxt);
            if constexpr (SP2) {
            PG8_LDB(B0, 0, 0); PG8_LDB(B1, 0, 1); PG8_SCHED; PG8_LDA(At, 0, 0); PG8_STAGE(PG8_SA(1, 1), a1 + hstep, voffA);
            PG8_WAIT_V(8); PG8_WAIT_L(0); PG8_BAR; PG8_MMA(0, 0, At, B0); PG8_MMA(0, 1, At, B1); PG8_BAR; PG8_SCHED;
            PG8_LDA(At, 0, 1); PG8_STAGE(PG8_SB(0, 0), b2, voffB); PG8_STAGE(PG8_SB(0, 1), b2 + hstep, voffB); PG8_STAGE(PG8_SA(0, 0), a2, voffA);
            PG8_WAIT_V(8); PG8_WAIT_L(0); PG8_BAR; PG8_MMA(1, 0, At, B0); PG8_MMA(1, 1, At, B1); PG8_BAR; PG8_SCHED;
            PG8_LDB(B0, 1, 0); PG8_LDB(B1, 1, 1); PG8_SCHED; PG8_LDA(At, 1, 0); PG8_STAGE(PG8_SA(0, 1), a2 + hstep, voffA);
            PG8_WAIT_V(8); PG8_WAIT_L(0); PG8_BAR; PG8_MMA(0, 0, At, B0); PG8_MMA(0, 1, At, B1); PG8_BAR; PG8_SCHED;
            PG8_LDA(At, 1, 1); PG8_STAGE(PG8_SB(1, 0), b3, voffB); PG8_STAGE(PG8_SB(1, 1), b3 + hstep, voffB); PG8_STAGE(PG8_SA(1, 0), a3, voffA);
            PG8_WAIT_V(8); PG8_WAIT_L(0); PG8_BAR; PG8_MMA(1, 0, At, B0); PG8_MMA(1, 1, At, B1); PG8_BAR; PG8_SCHED;
            } else {
            PG8_LDB(B0, 0, 0); PG8_SCHED; PG8_LDA(At, 0, 0); PG8_STAGE(PG8_SA(1, 1), a1 + hstep, voffA);
            PG8_WAIT_L(8); PG8_BAR; PG8_WAIT_L(0); PG8_MMA(0, 0, At, B0); PG8_BAR; PG8_SCHED;
            PG8_LDB(B1, 0, 1); PG8_STAGE(PG8_SB(0, 0), b2, voffB);
            PG8_BAR; PG8_WAIT_L(0); PG8_MMA(0, 1, At, B1); PG8_BAR;
            PG8_LDA(At, 0, 1); PG8_STAGE(PG8_SA(0, 0), a2, voffA);
            PG8_BAR; PG8_WAIT_L(0); PG8_MMA(1, 0, At, B0); PG8_BAR; PG8_SCHED;
            PG8_STAGE(PG8_SB(0, 1), b2 + hstep, voffB);
            PG8_WAIT_V(6); PG8_BAR; PG8_MMA(1, 1, At, B1); PG8_BAR;
            PG8_LDB(B0, 1, 0); PG8_SCHED; PG8_LDA(At, 1, 0); PG8_STAGE(PG8_SA(0, 1), a2 + hstep, voffA);
            PG8_WAIT_L(8); PG8_BAR; PG8_WAIT_L(0); PG8_MMA(0, 0, At, B0); PG8_BAR; PG8_SCHED;
            PG8_LDB(B1, 1, 1); PG8_STAGE(PG8_SB(1, 0), b3, voffB);
            PG8_BAR; PG8_WAIT_L(0); PG8_MMA(0, 1, At, B1); PG8_BAR;
            PG8_LDA(At, 1, 1); PG8_STAGE(PG8_SA(1, 0), a3, voffA);
            PG8_BAR; PG8_WAIT_L(0); PG8_MMA(1, 0, At, B0); PG8_BAR; PG8_SCHED;
            PG8_STAGE(PG8_SB(1, 1), b3 + hstep, voffB);
            PG8_WAIT_V(6); PG8_BAR; PG8_MMA(1, 1, At, B1); PG8_BAR;
            }
        }
        if constexpr (ALIGN_EPI) { if (wr == 0) PG8_BAR; }
        if constexpr (!Epi::AFTER_DRAIN) { E(acc, cur, wr, wc, fr, fq); S.done(cur); }
        if (!has_next) break;
#pragma unroll
        for (int a = 0; a < 2; ++a)
#pragma unroll
            for (int b = 0; b < 2; ++b)
#pragma unroll
                for (int m = 0; m < 4; ++m)
#pragma unroll
                    for (int n = 0; n < 2; ++n) acc[a][b][m][n] = (f32x4){0.f, 0.f, 0.f, 0.f};
        cur = nxt; cA = nA; cB = nB; ++ui;
        if constexpr (ALIGN_EPI) { if (wr == 1) PG8_BAR; }
    }
    PG8_WAIT_V(0);
    if constexpr (!ALIGN_EPI) { if (wr == 0) PG8_BAR; }
    PG8_BAR;
    if constexpr (Epi::AFTER_DRAIN) { E.fused(acc, cur, wr, wc, fr, fq, lds, wid, lane); S.done(cur); }
#undef PG8_SA
#undef PG8_SB
#undef PG8_STAGE
#undef PG8_LDA
#undef PG8_LDB
#undef PG8_MMA
#undef PG8_WAIT_V
#undef PG8_WAIT_L
#undef PG8_BAR
#undef PG8_SCHED
}
}
#define GAS __attribute__((address_space(1)))
#define LAS __attribute__((address_space(3)))
typedef unsigned short bf16;
typedef unsigned v4u __attribute__((ext_vector_type(4)));
typedef float f32x4 __attribute__((ext_vector_type(4)));
typedef short bf16x8 __attribute__((ext_vector_type(8)));
typedef GAS unsigned gu32;
typedef GAS unsigned long long gu64;
#define RLX_AGENT __ATOMIC_RELAXED, __HIP_MEMORY_SCOPE_AGENT
#define LDS_WAIT() asm volatile("s_waitcnt lgkmcnt(0)" ::: "memory")
#define VM_WAIT() asm volatile("s_waitcnt vmcnt(0)" ::: "memory")
__device__ __forceinline__ unsigned long long rt() { return __builtin_amdgcn_s_memrealtime(); }
__device__ __forceinline__ unsigned f2bf(float f) { unsigned u = __builtin_bit_cast(unsigned, f); return (u + 0x7fffu + ((u >> 16) & 1u)) >> 16; }
__device__ __forceinline__ unsigned pk2(float lo, float hi) { return f2bf(lo) | (f2bf(hi) << 16); }

#define XB_TMO      128
#define XB_XCNT(j)  (256  + 64 * (j))
#define XB_XSUB(j)  (1280 + 64 * (j))
#define XB_XGEN(j)  (2304 + 64 * (j))
#define XB_TOP      3328
#define XB_TOPGEN   3392
#define XCD_BAR_WORDS 3456
#define XB_SPIN_CAP (1u << 18)

__device__ __forceinline__ unsigned xb_ld(unsigned* p)              { return __hip_atomic_load(p, __ATOMIC_RELAXED, __HIP_MEMORY_SCOPE_AGENT); }
__device__ __forceinline__ unsigned xb_add(unsigned* p, unsigned v) { return __hip_atomic_fetch_add(p, v, __ATOMIC_RELAXED, __HIP_MEMORY_SCOPE_AGENT); }
__device__ __forceinline__ unsigned xb_xcc_id() { return (unsigned)__builtin_amdgcn_s_getreg((3 << 11) | 20) & 0xFu; }
#define XB_SPIN(cond, bar) do { unsigned _sp = 0; while (cond) { __builtin_amdgcn_s_sleep(1); \
    if ((++_sp & 255u) == 0u) { if (xb_ld(&(bar)[XB_TMO])) break; if (_sp > XB_SPIN_CAP) { atomicAdd(&(bar)[XB_TMO], 1u); break; } } } } while (0)

struct XcdBarrier {
    unsigned* bar; unsigned x;
    volatile LAS unsigned* st;
};

__device__ __forceinline__ XcdBarrier xcd_barrier_post(unsigned* bar, volatile LAS unsigned* st) {
    XcdBarrier b; b.bar = bar; b.x = xb_xcc_id(); b.st = st;
    if (threadIdx.x == 0) (void)xb_add(&bar[XB_XCNT(b.x)], 1u);
    return b;
}
__device__ __forceinline__ void xcd_barrier_complete(unsigned* bar, unsigned x, unsigned& nloc, unsigned& nx) {
    const unsigned G = gridDim.x * gridDim.y * gridDim.z;
    unsigned sum, cnt, mine, sp = 0u;
    for (;;) {
        sum = 0u; cnt = 0u; mine = 0u;
#pragma unroll
        for (unsigned j = 0; j < 16; ++j) { const unsigned c = xb_ld(&bar[XB_XCNT(j)]); sum += c; cnt += (c > 0u) ? 1u : 0u; mine = (j == x) ? c : mine; }
        if (sum == G) break;
        __builtin_amdgcn_s_sleep(1);
        if ((++sp & 255u) == 0u) { if (xb_ld(&bar[XB_TMO])) break; if (sp > XB_SPIN_CAP) { atomicAdd(&bar[XB_TMO], 1u); break; } }
    }
    nloc = mine > 0u ? mine : 1u; nx = cnt > 0u ? cnt : 1u;
}

__device__ __forceinline__ void xcd_barrier(const XcdBarrier& b) {
    asm volatile("s_waitcnt vmcnt(0)" ::: "memory");
    __syncthreads();
    if (threadIdx.x == 0) {
        unsigned* bar = b.bar;
        __builtin_amdgcn_s_waitcnt(0);
        unsigned nloc = b.st[0], nx = b.st[1];
        if (nloc == 0u) { xcd_barrier_complete(bar, b.x, nloc, nx); b.st[0] = nloc; b.st[1] = nx; }
        const unsigned old = xb_add(&bar[XB_XSUB(b.x)], 1u);
        const unsigned gen = old / nloc;
        if (old + 1u == (gen + 1u) * nloc) {
            __builtin_amdgcn_fence(__ATOMIC_RELEASE, "agent");
            asm volatile("s_waitcnt vmcnt(0)" ::: "memory");
            const unsigned og = xb_add(&bar[XB_TOP], 1u);
            const unsigned tg = og / nx;
            if (og + 1u == (tg + 1u) * nx) xb_add(&bar[XB_TOPGEN], 1u);
            else XB_SPIN(xb_ld(&bar[XB_TOPGEN]) == tg, bar);
            __builtin_amdgcn_fence(__ATOMIC_ACQUIRE, "agent");
            xb_add(&bar[XB_XGEN(b.x)], 1u);
            asm volatile("s_waitcnt vmcnt(0)" ::: "memory");
        } else {
            XB_SPIN(xb_ld(&bar[XB_XGEN(b.x)]) == gen, bar);
            __builtin_amdgcn_fence(__ATOMIC_ACQUIRE, "agent");
            asm volatile("s_waitcnt vmcnt(0)" ::: "memory");
        }
    }
    __syncthreads();
}
constexpr int BATCH = 2, SEQ = 16384, DM = 1024, TOK = BATCH * SEQ;
constexpr int FF = 2816, NHEAD = 16, HD = 64, NGRP = 4;
constexpr int FOXN = 3088, FOXNP = 3328, NSAN = 2608, NSANP = 2816;
constexpr int NCMP = 1023, NCMPP = 1024, NSELB = 256;
constexpr float DN_ALPHA = 1.4142135623730951f, LN_EPS = 1e-5f, LOG2E = 1.4426950408889634f;
constexpr int NWAVES = 8, NTHREADS = 512;
constexpr int N_PHASES = 19;
#ifndef MK_PER_PHASE
#define MK_PER_PHASE 0
#endif
__device__ const unsigned char T5B[128] = {0, 1, 2, 3, 4, 5, 6, 7, 8, 9, 10, 11, 12, 13, 14, 15, 16, 16, 16, 17, 17, 18, 18, 18, 19, 19, 19, 20, 20, 20, 20, 21, 21, 21, 21, 22, 22, 22, 22, 22, 23, 23, 23, 23, 23, 23, 24, 24, 24, 24, 24, 24, 25, 25, 25, 25, 25, 25, 25, 26, 26, 26, 26, 26, 26, 26, 26, 27, 27, 27, 27, 27, 27, 27, 27, 27, 27, 28, 28, 28, 28, 28, 28, 28, 28, 28, 28, 29, 29, 29, 29, 29, 29, 29, 29, 29, 29, 29, 29, 30, 30, 30, 30, 30, 30, 30, 30, 30, 30, 30, 30, 30, 30, 31, 31, 31, 31, 31, 31, 31, 31, 31, 31, 31, 31, 31, 31, 31};
__device__ __forceinline__ int t5_bucket(int d) { return d >= 113 ? 31 : (int)T5B[d < 0 ? 0 : d]; }

constexpr size_t MiB = 1u << 20;
constexpr size_t WS_CTL = 0, CTL_ZERO_BYTES = 1 * MiB;
constexpr size_t WS_WFOXIN = 2 * MiB, WS_WFOXOUT = 9 * MiB, WS_WNSAIN = 11 * MiB, WS_WNSAOUT = 17 * MiB;
constexpr size_t WS_WFFIN0 = 19 * MiB, WS_WFFIN1 = 30 * MiB, WS_WFFOUT0 = 41 * MiB, WS_WFFOUT1 = 47 * MiB;
constexpr size_t WS_MOD = 53 * MiB;
constexpr size_t WS_CB1 = 53 * MiB + 512 * 1024;
constexpr size_t WS_FLOGIT = 54 * MiB;
constexpr size_t WS_G = 56 * MiB;
constexpr size_t WS_GATES = 58 * MiB;
constexpr size_t WS_KCMP = 64 * MiB, WS_VCMP = 65 * MiB;
constexpr size_t WS_SEL = 66 * MiB;
constexpr size_t WS_HBUF = 70 * MiB;
constexpr size_t WS_R = 134 * MiB;
constexpr size_t WS_OC = 326 * MiB;
constexpr size_t WS_END = 454 * MiB;
constexpr int CW_BAR = 4096;

constexpr int RING_BYTES = 131072, LDSCTL_OFF = RING_BYTES, MISC_OFF = LDSCTL_OFF + 320, LDS_BYTES = 147456;
__device__ __forceinline__ float bf2f(unsigned short u) { return __uint_as_float((unsigned)u << 16); }
__device__ __forceinline__ void bf8_to_f(const v4u w, float* o) {
    o[0] = __uint_as_float(w.x << 16); o[1] = __uint_as_float(w.x & 0xffff0000u); o[2] = __uint_as_float(w.y << 16); o[3] = __uint_as_float(w.y & 0xffff0000u);
    o[4] = __uint_as_float(w.z << 16); o[5] = __uint_as_float(w.z & 0xffff0000u); o[6] = __uint_as_float(w.w << 16); o[7] = __uint_as_float(w.w & 0xffff0000u);
}
__device__ __forceinline__ float wave_sum(float v) {
#pragma unroll
    for (int o = 1; o < 64; o <<= 1) v += __shfl_xor(v, o);
    return v;
}
__device__ __forceinline__ float wave_max(float v) {
#pragma unroll
    for (int o = 1; o < 64; o <<= 1) v = fmaxf(v, __shfl_xor(v, o));
    return v;
}
struct Ctx { int tid, lane, wave, vcu, G; unsigned char* lds; };

__device__ __forceinline__ void tr_item(const float* W, int ldw, int K, bf16* WT, int k0, int nd0, int sc0, int nvalid, float* scr, int lane) {
    const int col = lane & 31;
#pragma unroll 8
    for (int i = 0; i < 32; ++i) { const int kk = 2 * i + (lane >> 5); scr[kk * 33 + col] = col < nvalid ? W[(size_t)(k0 + kk) * ldw + sc0 + col] : 0.f; }
    LDS_WAIT(); asm volatile("" ::: "memory");
    const int c = lane & 7;
#pragma unroll
    for (int j = 0; j < 4; ++j) { const int n = (lane >> 3) + 8 * j; const float* s = scr + (8 * c) * 33 + n;
        v4u o; o.x = pk2(s[0 * 33], s[1 * 33]); o.y = pk2(s[2 * 33], s[3 * 33]); o.z = pk2(s[4 * 33], s[5 * 33]); o.w = pk2(s[6 * 33], s[7 * 33]);
        *(v4u*)(WT + (size_t)(nd0 + n) * K + k0 + 8 * c) = o; }
    LDS_WAIT(); asm volatile("" ::: "memory");
}
__device__ __forceinline__ void p_prep(const Ctx& C, const float* const* in, unsigned char* ws) {
    float* scr = (float*)(C.lds + C.wave * 16384);
    const int gw = C.vcu * NWAVES + C.wave, NGW = C.G * NWAVES;
    constexpr int I_FOXIN = 16 * (FOXNP / 32), I_SQ = 16 * 32, I_NSAIN = 16 * (NSANP / 32), I_FFIN = 16 * (2 * FF / 32), I_FFOUT = (FF / 64) * 32;
    constexpr int NITEMS = I_FOXIN + I_SQ + I_NSAIN + I_SQ + 2 * I_FFIN + 2 * I_FFOUT;
    for (int it = gw; it < NITEMS; it += NGW) {
        int r = it;
        if (r < I_FOXIN) { const int nb = r % (FOXNP / 32), kb = r / (FOXNP / 32); const int nd0 = 32 * nb; int nv = FOXN - nd0; nv = nv < 0 ? 0 : (nv > 32 ? 32 : nv);
            tr_item(in[6], FOXN, DM, (bf16*)(ws + WS_WFOXIN), 64 * kb, nd0, nd0, nv, scr, C.lane); continue; } r -= I_FOXIN;
        if (r < I_SQ) { const int nb = r % 32, kb = r / 32; tr_item(in[8], DM, DM, (bf16*)(ws + WS_WFOXOUT), 64 * kb, 32 * nb, 32 * nb, 32, scr, C.lane); continue; } r -= I_SQ;
        if (r < I_NSAIN) { const int nb = r % (NSANP / 32), kb = r / (NSANP / 32); const int nd0 = 32 * nb; int nv = NSAN - nd0; nv = nv < 0 ? 0 : (nv > 32 ? 32 : nv);
            tr_item(in[9], NSAN, DM, (bf16*)(ws + WS_WNSAIN), 64 * kb, nd0, nd0, nv, scr, C.lane); continue; } r -= I_NSAIN;
        if (r < I_SQ) { const int nb = r % 32, kb = r / 32; tr_item(in[14], DM, DM, (bf16*)(ws + WS_WNSAOUT), 64 * kb, 32 * nb, 32 * nb, 32, scr, C.lane); continue; } r -= I_SQ;
        if (r < 2 * I_FFIN) { const int l = r / I_FFIN; r -= l * I_FFIN; const int nb = r % (2 * FF / 32), kb = r / (2 * FF / 32); const int nd0 = 32 * nb, tile = nd0 >> 8, j = nd0 & 255;
            const int sc0 = j < 128 ? 128 * tile + j : FF + 128 * tile + (j - 128);
            tr_item(in[16] + (size_t)l * DM * 2 * FF, 2 * FF, DM, (bf16*)(ws + (l ? WS_WFFIN1 : WS_WFFIN0)), 64 * kb, nd0, sc0, 32, scr, C.lane); continue; } r -= 2 * I_FFIN;
        { const int l = r / I_FFOUT; r -= l * I_FFOUT; const int nb = r % 32, kb = r / 32;
            tr_item(in[17] + (size_t)l * FF * DM, DM, FF, (bf16*)(ws + (l ? WS_WFFOUT1 : WS_WFFOUT0)), 64 * kb, 32 * nb, 32 * nb, 32, scr, C.lane); }
    }
    __syncthreads();
    float* cs = (float*)C.lds;
    for (int i = C.tid; i < BATCH * DM; i += NTHREADS) { const float v = in[1][i]; cs[i] = v / (1.f + __expf(-v)); }
    __syncthreads();
    float* mod = (float*)(ws + WS_MOD);
    for (int o = blockIdx.x * NTHREADS + C.tid; o < 2 * BATCH * 6 * DM; o += C.G * NTHREADS) {
        const int col = o % (6 * DM), b = (o / (6 * DM)) % BATCH, l = o / (6 * DM * BATCH);
        const float* w = in[2] + (size_t)l * DM * 6 * DM + col; const float* cb = cs + b * DM;
        float acc = in[3][l * 6 * DM + col];
#pragma unroll 8
        for (int k = 0; k < DM; ++k) acc += cb[k] * w[(size_t)k * 6 * DM];
        mod[o] = acc;
    }
    float* cb1 = (float*)(ws + WS_CB1);
    for (int o = blockIdx.x * NTHREADS + C.tid; o < 2 * 128; o += C.G * NTHREADS) {
        const int kv = o >> 7, c = o & 127; const float* pos = in[11] + kv * 2048; const float* w1 = in[12] + (size_t)kv * 2048 * 128 + c;
        float acc = 0.f;
        for (int i = 0; i < 2048; ++i) acc += pos[i] * w1[(size_t)i * 128];
        cb1[o] = acc;
    }
    __syncthreads();
}

__device__ __forceinline__ void p_modrows(const Ctx& C, const float* x, const float* modl  , int sh_off, int sc_off, bf16* h) {
    const int gw = C.vcu * NWAVES + C.wave, NGW = C.G * NWAVES;
    for (int m = gw; m < TOK; m += NGW) {
        const int b = m / SEQ; const f32x4* xr = (const f32x4*)(x + (size_t)m * DM) + C.lane;
        const f32x4* sc = (const f32x4*)(modl + b * 6 * DM + sc_off) + C.lane; const f32x4* sh = (const f32x4*)(modl + b * 6 * DM + sh_off) + C.lane;
        unsigned long long* o8 = (unsigned long long*)(h + (size_t)m * DM) + C.lane;
#pragma unroll
        for (int j = 0; j < 4; ++j) { const f32x4 v = xr[64 * j] * (sc[64 * j] + 1.0f) + sh[64 * j];
            o8[64 * j] = (unsigned long long)pk2(v.x, v.y) | ((unsigned long long)pk2(v.z, v.w) << 32); }
    }
}
__device__ __forceinline__ void p_lnrows(const Ctx& C, float* xz, const float* lg, const float* lb, const float* modl, int sh_off, int sc_off, bf16* h) {
    const int gw = C.vcu * NWAVES + C.wave, NGW = C.G * NWAVES;
    for (int m = gw; m < TOK; m += NGW) {
        const int b = m / SEQ; f32x4* xr = (f32x4*)(xz + (size_t)m * DM) + C.lane;
        f32x4 v[4]; float s = 0.f;
#pragma unroll
        for (int j = 0; j < 4; ++j) { v[j] = xr[64 * j]; s += (v[j].x + v[j].y) + (v[j].z + v[j].w); }
        const float mean = wave_sum(s) * (1.f / DM); float s2 = 0.f;
#pragma unroll
        for (int j = 0; j < 4; ++j) { v[j] = v[j] - mean; s2 += (v[j].x * v[j].x + v[j].y * v[j].y) + (v[j].z * v[j].z + v[j].w * v[j].w); }
        const float rstd = 1.f / sqrtf(wave_sum(s2) * (1.f / DM) + LN_EPS);
#pragma unroll
        for (int j = 0; j < 4; ++j) { const f32x4 g = ((const f32x4*)lg)[C.lane + 64 * j], bb = ((const f32x4*)lb)[C.lane + 64 * j]; v[j] = v[j] * rstd * g + bb; xr[64 * j] = v[j]; }
        if (h) {
            const f32x4* sc = (const f32x4*)(modl + b * 6 * DM + sc_off) + C.lane; const f32x4* sh = (const f32x4*)(modl + b * 6 * DM + sh_off) + C.lane;
            unsigned long long* o8 = (unsigned long long*)(h + (size_t)m * DM) + C.lane;
#pragma unroll
            for (int j = 0; j < 4; ++j) { const f32x4 w = v[j] * (sc[64 * j] + 1.0f) + sh[64 * j];
                o8[64 * j] = (unsigned long long)pk2(w.x, w.y) | ((unsigned long long)pk2(w.z, w.w) << 32); }
        }
    }
}

__device__ __forceinline__ void p_scan(const Ctx& C, const float* flogit, const float* bf, float* Gf) {
    const int gw = C.vcu * NWAVES + C.wave;
    if (gw >= BATCH * NHEAD) return;
    const int b = gw / NHEAD, h = gw % NHEAD; const float bias = bf[h];
    double carry = 0.0;
    for (int t0 = 0; t0 < SEQ; t0 += 64) {
        const float xv = flogit[(size_t)(b * SEQ + t0 + C.lane) * 16 + h] + bias;
        float ls = fminf(xv, 0.f) - log1pf(__expf(-fabsf(xv)));
        double v = (double)ls;
#pragma unroll
        for (int o = 1; o < 64; o <<= 1) { const double u = __shfl_up(v, o); if (C.lane >= o) v += u; }
        const double tot = __shfl(v, 63);
        Gf[(size_t)gw * SEQ + t0 + C.lane] = (float)((carry + v) * (double)LOG2E);
        carry += tot;
    }
}

__device__ __forceinline__ void p_fox_naive(const Ctx& C, const bf16* Q, const bf16* K, const bf16* V, const float* Gf, bf16* O) {
    float* Kt = (float*)C.lds; float* Vt = Kt + 4096; float* Gt = Vt + 4096;
    const int tid = C.tid;
    for (int u = C.vcu; u < 1024; u += C.G) {
        const int bh = u & 31, kk = u >> 5, s = kk & 7, it = kk >> 3;
        const int rb = it == 0 ? s : (it == 1 ? 15 - s : (it == 2 ? 16 + s : 31 - s));
        const int b = bh >> 4, h = bh & 15, row = rb * 512 + tid;
        float q[64], o[64];
        { const v4u* qp = (const v4u*)(Q + (size_t)(b * SEQ + row) * DM + h * HD);
#pragma unroll
          for (int i = 0; i < 8; ++i) bf8_to_f(qp[i], q + 8 * i); }
#pragma unroll
        for (int i = 0; i < 64; ++i) o[i] = 0.f;
        const float gi = Gf[(size_t)bh * SEQ + row];
        float m = -INFINITY, l = 0.f;
        const int jend = (rb + 1) * 512;
        for (int j0 = 0; j0 < jend; j0 += 64) {
            __syncthreads();
            { const int key = tid >> 3, ch = tid & 7; const size_t off = (size_t)(b * SEQ + j0 + key) * DM + h * HD + ch * 8;
              float t8[8]; bf8_to_f(*(const v4u*)(K + off), t8);
              *(f32x4*)(Kt + key * 64 + ch * 8) = (f32x4){t8[0], t8[1], t8[2], t8[3]}; *(f32x4*)(Kt + key * 64 + ch * 8 + 4) = (f32x4){t8[4], t8[5], t8[6], t8[7]};
              bf8_to_f(*(const v4u*)(V + off), t8);
              *(f32x4*)(Vt + key * 64 + ch * 8) = (f32x4){t8[0], t8[1], t8[2], t8[3]}; *(f32x4*)(Vt + key * 64 + ch * 8 + 4) = (f32x4){t8[4], t8[5], t8[6], t8[7]};
              if (tid < 64) Gt[tid] = Gf[(size_t)bh * SEQ + j0 + tid]; }
            __syncthreads();
            if (j0 > row) continue;
            const int kmax = (row - j0) < 63 ? (row - j0) : 63;
            for (int key = 0; key <= kmax; ++key) {
                const f32x4* kr = (const f32x4*)(Kt + key * 64);
                float d0 = 0.f, d1 = 0.f, d2 = 0.f, d3 = 0.f;
#pragma unroll
                for (int i = 0; i < 16; ++i) { const f32x4 kv = kr[i]; d0 += q[4 * i] * kv.x; d1 += q[4 * i + 1] * kv.y; d2 += q[4 * i + 2] * kv.z; d3 += q[4 * i + 3] * kv.w; }
                const float sv = ((d0 + d1) + (d2 + d3)) + (gi - Gt[key]);
                if (sv > m) { const float f = exp2f(m - sv); l *= f;
#pragma unroll
                    for (int i = 0; i < 64; ++i) o[i] *= f;
                    m = sv; }
                const float p = exp2f(sv - m); l += p;
                const f32x4* vr = (const f32x4*)(Vt + key * 64);
#pragma unroll
                for (int i = 0; i < 16; ++i) { const f32x4 vv = vr[i]; o[4 * i] += p * vv.x; o[4 * i + 1] += p * vv.y; o[4 * i + 2] += p * vv.z; o[4 * i + 3] += p * vv.w; }
            }
        }
        const float rl = 1.f / l;
        v4u* op = (v4u*)(O + (size_t)(b * SEQ + row) * DM + h * HD);
#pragma unroll
        for (int i = 0; i < 8; ++i) { v4u w; w.x = pk2(o[8 * i] * rl, o[8 * i + 1] * rl); w.y = pk2(o[8 * i + 2] * rl, o[8 * i + 3] * rl); w.z = pk2(o[8 * i + 4] * rl, o[8 * i + 5] * rl); w.w = pk2(o[8 * i + 6] * rl, o[8 * i + 7] * rl); op[i] = w; }
    }
    __syncthreads();
}

__device__ __forceinline__ void p_compress_naive(const Ctx& C, const bf16* KV  , size_t kv_stride, const float* w1a, const float* w2a, const float* cb1, bf16* kcmp, bf16* vcmp) {
    const int gw = C.vcu * NWAVES + C.wave, NGW = C.G * NWAVES;
    float* hid = (float*)(C.lds + C.wave * 4096);
    for (int u = gw; u < 2 * BATCH * NGRP * 256; u += NGW) {
        const int nq = u & 255, g = (u >> 8) & 3, b = (u >> 10) & 1, kv = u >> 11;
        const bf16* src = KV + (size_t)kv * kv_stride + (size_t)b * SEQ * 256 + g * 64;
        const float* w1 = w1a + (size_t)kv * 2048 * 128; const float* w2 = w2a + (size_t)kv * 128 * 64;
        float a0[4], a1[4];
#pragma unroll
        for (int j = 0; j < 4; ++j) { a0[j] = cb1[kv * 128 + C.lane]; a1[j] = cb1[kv * 128 + 64 + C.lane]; }
        const int n0 = nq * 4;
        for (int i = 0; i < 2048; ++i) {
            const float wa = w1[(size_t)i * 128 + C.lane], wb = w1[(size_t)i * 128 + 64 + C.lane];
#pragma unroll
            for (int j = 0; j < 4; ++j) { const int n = n0 + j; const int tok = 16 * n + (i >> 6);
                const float xv = (n < NCMP) ? bf2f(src[(size_t)tok * 256 + (i & 63)]) : 0.f;
                a0[j] += xv * wa; a1[j] += xv * wb; }
        }
#pragma unroll
        for (int j = 0; j < 4; ++j) { hid[j * 128 + C.lane] = a0[j] / (1.f + __expf(-a0[j])); hid[j * 128 + 64 + C.lane] = a1[j] / (1.f + __expf(-a1[j])); }
        LDS_WAIT(); asm volatile("" ::: "memory");
        float oo[4] = {0.f, 0.f, 0.f, 0.f};
        for (int c = 0; c < 128; ++c) { const float w = w2[c * 64 + C.lane];
#pragma unroll
            for (int j = 0; j < 4; ++j) oo[j] += hid[j * 128 + c] * w; }
        bf16* dst = (kv ? vcmp : kcmp) + (size_t)((b * NGRP + g) * NCMPP) * 64;
#pragma unroll
        for (int j = 0; j < 4; ++j) { const int n = n0 + j; dst[(size_t)n * 64 + C.lane] = (n < NCMP) ? (bf16)f2bf(oo[j]) : (bf16)0; }
        LDS_WAIT(); asm volatile("" ::: "memory");
    }
}

template <int MODE  >
__device__ __forceinline__ void wave_attn(const float (&q)[64], int t, int nchunks, int nvis, const int* bl, const bf16* Kb, const bf16* Vb, int pitch, const float* relh  ,
                                          float* sc, float& l_out, float& o_out, int lane) {
    float mx = -INFINITY;
    for (int c = 0; c < nchunks; ++c) {
        const int slot = 64 * c + lane; int key, dist; bool valid;
        if (MODE == 0) { key = slot; valid = slot < nvis; dist = t - (16 * slot + 31); }
        else if (MODE == 1) { key = 64 * bl[c] + lane; valid = key <= t; dist = t - key; }
        else { key = t - 511 + slot; valid = key >= 0; dist = t - key; }
        float s = -INFINITY;
        if (valid) {
            const v4u* kp = (const v4u*)(Kb + (size_t)key * pitch); float d0 = 0.f, d1 = 0.f;
#pragma unroll
            for (int i = 0; i < 8; ++i) { float k8[8]; bf8_to_f(kp[i], k8);
#pragma unroll
                for (int e = 0; e < 8; e += 2) { d0 += q[8 * i + e] * k8[e]; d1 += q[8 * i + e + 1] * k8[e + 1]; } }
            s = (d0 + d1) + relh[16 * t5_bucket(dist)] * LOG2E;
        }
        sc[slot] = s; mx = fmaxf(mx, s);
    }
    mx = wave_max(mx);
    float ls = 0.f;
    if (mx == -INFINITY) { l_out = 0.f; o_out = 0.f; for (int c = 0; c < nchunks; ++c) sc[64 * c + lane] = 0.f; LDS_WAIT(); return; }
    for (int c = 0; c < nchunks; ++c) { const int slot = 64 * c + lane; const float s = sc[slot]; const float p = (s == -INFINITY) ? 0.f : exp2f(s - mx); sc[slot] = p; ls += p; }
    l_out = wave_sum(ls);
    LDS_WAIT(); asm volatile("" ::: "memory");
    float o = 0.f;
    const int ntot = (MODE == 0) ? nvis : 64 * nchunks;
    for (int slot = 0; slot < ntot; ++slot) {
        const float p = sc[slot];
        if (p != 0.f) { int key; if (MODE == 0) key = slot; else if (MODE == 1) key = 64 * bl[slot >> 6] + (slot & 63); else key = t - 511 + slot;
            o += p * bf2f(Vb[(size_t)key * pitch + lane]); }
    }
    o_out = o;
}
__device__ __forceinline__ void load_q(const bf16* Qrow, float* qs, float (&q)[64], int lane) {
    qs[lane] = bf2f(Qrow[lane]); LDS_WAIT(); asm volatile("" ::: "memory");
#pragma unroll
    for (int i = 0; i < 16; ++i) { const f32x4 v = ((const f32x4*)qs)[i]; q[4 * i] = v.x; q[4 * i + 1] = v.y; q[4 * i + 2] = v.z; q[4 * i + 3] = v.w; }
    asm volatile("" ::: "memory");
}
__device__ __forceinline__ void p_nsa_cmp_naive(const Ctx& C, const bf16* Q, const bf16* kcmp, const bf16* vcmp, const float* relb, float* OC, unsigned* SEL) {
    const int gw = C.vcu * NWAVES + C.wave, NGW = C.G * NWAVES, lane = C.lane;
    float* sc = (float*)(C.lds + C.wave * 10240); float* imp = sc + 1024; float* qs = imp + 1024;
    for (int u = gw; u < TOK * NGRP; u += NGW) {
        const int g = u & 3, tok = u >> 2, b = tok / SEQ, t = tok % SEQ;
        int nvis = t >= 31 ? ((t - 31) / 16 + 1) : 0; if (nvis > NCMP) nvis = NCMP;
        const int nch = (nvis + 63) >> 6;
        for (int i = lane; i < 1024; i += 64) imp[i] = 0.f;
        const bf16* Kb = kcmp + (size_t)((b * NGRP + g) * NCMPP) * 64; const bf16* Vb = vcmp + (size_t)((b * NGRP + g) * NCMPP) * 64;
        for (int hh = 0; hh < 4; ++hh) {
            const int head = g * 4 + hh; float q[64];
            load_q(Q + (size_t)tok * DM + head * HD, qs, q, lane);
            float l, o;
            wave_attn<0>(q, t, nch, nvis, nullptr, Kb, Vb, 64, relb + head, sc, l, o, lane);
            const float rl = l > 0.f ? 1.f / fmaxf(l, 1e-30f) : 0.f;
            OC[(size_t)tok * DM + head * HD + lane] = o * rl;
            for (int c = 0; c < nch; ++c) imp[64 * c + lane] += sc[64 * c + lane] * rl;
            LDS_WAIT(); asm volatile("" ::: "memory");
        }
        const int cur = t >> 6;
        float val[4];
#pragma unroll
        for (int k = 0; k < 4; ++k) { const int j = lane + 64 * k; float v = 0.f;
#pragma unroll
            for (int a = -1; a <= 3; ++a) { const int idx = 4 * j + a; if (idx >= 0 && idx < nvis) v += imp[idx]; }
            const bool forced = (j == 0) || (j == cur) || (j == cur - 1);
            val[k] = forced ? 1e9f : (j <= cur ? v : -1e30f); }
        unsigned mw[8];
#pragma unroll
        for (int w = 0; w < 8; ++w) mw[w] = 0u;
        for (int r = 0; r < 16; ++r) {
            float bv = val[0]; int bj = lane;
#pragma unroll
            for (int k = 1; k < 4; ++k) if (val[k] > bv) { bv = val[k]; bj = lane + 64 * k; }
#pragma unroll
            for (int o = 1; o < 64; o <<= 1) { const float ov = __shfl_xor(bv, o); const int oj = __shfl_xor(bj, o); if (ov > bv || (ov == bv && oj < bj)) { bv = ov; bj = oj; } }
            if (bv > -0.5e30f) {
#pragma unroll
                for (int w = 0; w < 8; ++w) mw[w] |= (w == (bj >> 5)) ? (1u << (bj & 31)) : 0u;
            }
            if ((bj & 63) == lane) {
#pragma unroll
                for (int k = 0; k < 4; ++k) if (k == (bj >> 6)) val[k] = -3e38f;
            }
        }
        if (lane < 8) { unsigned w = mw[0];
#pragma unroll
            for (int k = 1; k < 8; ++k) if (lane == k) w = mw[k];
            SEL[(size_t)u * 8 + lane] = w; }
    }
}
__device__ __forceinline__ void p_nsa_selwin_naive(const Ctx& C, const bf16* Q, const bf16* KVb, size_t kv_stride, const float* relb, const float* OC, const unsigned* SEL, const float* gates, bf16* O) {
    const int gw = C.vcu * NWAVES + C.wave, NGW = C.G * NWAVES, lane = C.lane;
    float* sc = (float*)(C.lds + C.wave * 10240); int* bl = (int*)(sc + 1024); float* qs = sc + 1024 + 64;
    const bf16* KS = KVb + 2 * kv_stride; const bf16* VS = KVb + 3 * kv_stride; const bf16* KW = KVb + 4 * kv_stride; const bf16* VW = KVb + 5 * kv_stride;
    for (int u = gw; u < TOK * NGRP; u += NGW) {
        const int g = u & 3, tok = u >> 2, b = tok / SEQ, t = tok % SEQ;
        int nsel = 0;
        for (int w = 0; w < 8; ++w) { unsigned mwv = SEL[(size_t)u * 8 + w]; while (mwv) { const int bit = __builtin_ctz(mwv); mwv &= mwv - 1; if (lane == 0) bl[nsel] = 32 * w + bit; ++nsel; } }
        LDS_WAIT(); asm volatile("" ::: "memory");
        const size_t boff = (size_t)b * SEQ * 256 + g * 64;
        for (int hh = 0; hh < 4; ++hh) {
            const int head = g * 4 + hh; float q[64];
            load_q(Q + (size_t)tok * DM + head * HD, qs, q, lane);
            float ls, os, lw, ow;
            wave_attn<1>(q, t, nsel, 0, bl, KS + boff, VS + boff, 256, relb + head, sc, ls, os, lane);
            LDS_WAIT(); asm volatile("" ::: "memory");
            wave_attn<2>(q, t, 8, 0, nullptr, KW + boff, VW + boff, 256, relb + head, sc, lw, ow, lane);
            LDS_WAIT(); asm volatile("" ::: "memory");
            const float* gt = gates + (size_t)tok * 48;
            const float oc = OC[(size_t)tok * DM + head * HD + lane];
            const float outv = gt[head] * oc + gt[16 + head] * (os / fmaxf(ls, 1e-30f)) + gt[32 + head] * (ow / fmaxf(lw, 1e-30f));
            O[(size_t)tok * DM + head * HD + lane] = (bf16)f2bf(outv);
        }
    }
}
struct Args { const float* in[18]; float* out; unsigned char* ws; int ph_lo, ph_hi; };
__global__ void __launch_bounds__(NTHREADS, 2) fwd_kernel(Args args) {
    extern __shared__ __attribute__((aligned(16))) unsigned char lds[];
    Ctx C; C.tid = threadIdx.x; C.lane = C.tid & 63; C.wave = __builtin_amdgcn_readfirstlane(C.tid >> 6); C.G = gridDim.x; C.lds = lds;
    { const int bx = blockIdx.x; C.vcu = (C.G % 8 == 0) ? (bx % 8) * (C.G / 8) + bx / 8 : bx; }
    unsigned char* ws = args.ws; const float* const* in = args.in;
    gu32* ctl = (gu32*)(ws + WS_CTL);
    LAS unsigned char* ldsl = (LAS unsigned char*)lds;
    volatile LAS unsigned* MISC = (volatile LAS unsigned*)(ldsl + MISC_OFF);
    for (int u = C.tid; u < (LDS_BYTES - LDSCTL_OFF) / 4; u += NTHREADS) ((LAS unsigned*)(ldsl + LDSCTL_OFF))[u] = 0u;
    __syncthreads();
    const int lo = args.ph_lo, hi = args.ph_hi;
    XcdBarrier bar; bar.bar = (unsigned*)(ctl + CW_BAR); bar.x = 0; bar.st = nullptr;
    if (hi - lo > 1) bar = xcd_barrier_post((unsigned*)(ctl + CW_BAR), MISC + 8);
#define IN(k) (lo <= (k) && (k) < hi)
#define SEAM(k) do { if (IN(k) && IN((k) + 1)) xcd_barrier(bar); } while (0)
    bf16* Wfoxin = (bf16*)(ws + WS_WFOXIN); bf16* Wfoxout = (bf16*)(ws + WS_WFOXOUT); bf16* Wnsain = (bf16*)(ws + WS_WNSAIN); bf16* Wnsaout = (bf16*)(ws + WS_WNSAOUT);
    float* mod = (float*)(ws + WS_MOD); float* cb1 = (float*)(ws + WS_CB1); float* flogit = (float*)(ws + WS_FLOGIT); float* Gf = (float*)(ws + WS_G); float* gates = (float*)(ws + WS_GATES);
    bf16* kcmp = (bf16*)(ws + WS_KCMP); bf16* vcmp = (bf16*)(ws + WS_VCMP); unsigned* SEL = (unsigned*)(ws + WS_SEL);
    bf16* HB = (bf16*)(ws + WS_HBUF); bf16* QO = (bf16*)(ws + WS_R); bf16* KB = (bf16*)(ws + WS_R + 64 * MiB); bf16* VB = (bf16*)(ws + WS_R + 128 * MiB);
    bf16* KV6 = (bf16*)(ws + WS_R + 64 * MiB); const size_t KVS = (size_t)(16 * MiB) / 2;
    bf16* UB = (bf16*)(ws + WS_R); float* OC = (float*)(ws + WS_OC);
    float* XZ = args.out;
    const float* x_in = in[0];

    if (IN(0)) { p_prep(C, in, ws); } SEAM(0);
    if (IN(1)) { p_modrows(C, x_in, mod, 0, DM, HB); } SEAM(1);
    if (IN(2)) { pg8::Gemm g{HB, Wfoxin, TOK, FOXNP, DM}; pg8::StaticOrder S; S.init(TOK, FOXNP, C.G, (int)blockIdx.x);
        pg8::EpiFoxIn E{QO, (size_t)(64 * MiB) / 2, flogit};
        pg8::gemm_phase<pg8::EpiFoxIn, pg8::StaticOrder, true, true>(ldsl, g, S, E); } SEAM(2);
    if (IN(3)) { p_scan(C, flogit, in[7], Gf); } SEAM(3);
    if (IN(4)) { p_fox_naive(C, QO, KB, VB, Gf, QO); } SEAM(4);
    if (IN(5)) { pg8::Gemm g{QO, Wfoxout, TOK, DM, DM}; pg8::StaticOrder S; S.init(TOK, DM, C.G, (int)blockIdx.x);
        pg8::EpiResid E{x_in, XZ, mod + 2 * DM, 6 * DM, SEQ, DN_ALPHA};
        pg8::gemm_phase<pg8::EpiResid, pg8::StaticOrder, true, true>(ldsl, g, S, E); } SEAM(5);
    if (IN(6)) { p_lnrows(C, XZ, in[4] + 0 * DM, in[5] + 0 * DM, mod, 3 * DM, 4 * DM, HB); } SEAM(6);
    if (IN(7)) { pg8::Gemm g{HB, (bf16*)(ws + WS_WFFIN0), TOK, 2 * FF, DM}; pg8::StaticOrder S; S.init(TOK, 2 * FF, C.G, (int)blockIdx.x);
        pg8::EpiSwiGLU E{UB, FF};
        pg8::gemm_phase<pg8::EpiSwiGLU, pg8::StaticOrder, true, true>(ldsl, g, S, E); } SEAM(7);
    if (IN(8)) { pg8::Gemm g{UB, (bf16*)(ws + WS_WFFOUT0), TOK, DM, FF}; pg8::StaticOrder S; S.init(TOK, DM, C.G, (int)blockIdx.x);
        pg8::EpiResid E{XZ, XZ, mod + 5 * DM, 6 * DM, SEQ, DN_ALPHA};
        pg8::gemm_phase<pg8::EpiResid, pg8::StaticOrder, true, true>(ldsl, g, S, E); } SEAM(8);
    const float* mod1 = mod + BATCH * 6 * DM;
    if (IN(9)) { p_lnrows(C, XZ, in[4] + 1 * DM, in[5] + 1 * DM, mod1, 0, DM, HB); } SEAM(9);
    if (IN(10)) { pg8::Gemm g{HB, Wnsain, TOK, NSANP, DM}; pg8::StaticOrder S; S.init(TOK, NSANP, C.G, (int)blockIdx.x);
        pg8::EpiNsaIn E{QO, KV6, KVS, gates, in[10]};
        pg8::gemm_phase<pg8::EpiNsaIn, pg8::StaticOrder, true, true>(ldsl, g, S, E); } SEAM(10);
    if (IN(11)) { p_compress_naive(C, KV6, KVS, in[12], in[13], cb1, kcmp, vcmp); } SEAM(11);
    if (IN(12)) { p_nsa_cmp_naive(C, QO, kcmp, vcmp, in[15], OC, SEL); } SEAM(12);
    if (IN(13)) { p_nsa_selwin_naive(C, QO, KV6, KVS, in[15], OC, SEL, gates, QO); } SEAM(13);
    if (IN(14)) { pg8::Gemm g{QO, Wnsaout, TOK, DM, DM}; pg8::StaticOrder S; S.init(TOK, DM, C.G, (int)blockIdx.x);
        pg8::EpiResid E{XZ, XZ, mod1 + 2 * DM, 6 * DM, SEQ, DN_ALPHA};
        pg8::gemm_phase<pg8::EpiResid, pg8::StaticOrder, true, true>(ldsl, g, S, E); } SEAM(14);
    if (IN(15)) { p_lnrows(C, XZ, in[4] + 2 * DM, in[5] + 2 * DM, mod1, 3 * DM, 4 * DM, HB); } SEAM(15);
    if (IN(16)) { pg8::Gemm g{HB, (bf16*)(ws + WS_WFFIN1), TOK, 2 * FF, DM}; pg8::StaticOrder S; S.init(TOK, 2 * FF, C.G, (int)blockIdx.x);
        pg8::EpiSwiGLU E{UB, FF};
        pg8::gemm_phase<pg8::EpiSwiGLU, pg8::StaticOrder, true, true>(ldsl, g, S, E); } SEAM(16);
    if (IN(17)) { pg8::Gemm g{UB, (bf16*)(ws + WS_WFFOUT1), TOK, DM, FF}; pg8::StaticOrder S; S.init(TOK, DM, C.G, (int)blockIdx.x);
        pg8::EpiResid E{XZ, XZ, mod1 + 5 * DM, 6 * DM, SEQ, DN_ALPHA};
        pg8::gemm_phase<pg8::EpiResid, pg8::StaticOrder, true, true>(ldsl, g, S, E); } SEAM(17);
    if (IN(18)) { p_lnrows(C, XZ, in[4] + 3 * DM, in[5] + 3 * DM, mod1, 0, 0, nullptr); }
#undef IN
#undef SEAM
}

extern "C" void kernel_launch(void* const* d_in, const int* in_sizes, int n_in, void* d_out, int out_size, void* d_ws, size_t ws_size, hipStream_t stream) {
    static int grid = 0;
    if (grid == 0) {
        if (n_in != 18 || in_sizes[0] != TOK * DM || out_size != TOK * DM || ws_size < WS_END) { fprintf(stderr, "kernel_launch: unexpected shapes (n_in %d, in0 %d, out %d, ws %zu)\n", n_in, n_in > 0 ? in_sizes[0] : -1, out_size, ws_size); grid = -1; return; }
        int dev = 0, cus = 0, per_cu = 0;
        if (hipGetDevice(&dev) != hipSuccess || hipDeviceGetAttribute(&cus, hipDeviceAttributeMultiprocessorCount, dev) != hipSuccess) { grid = -1; return; }
        if (hipFuncSetAttribute((const void*)fwd_kernel, hipFuncAttributeMaxDynamicSharedMemorySize, LDS_BYTES) != hipSuccess) { fprintf(stderr, "kernel_launch: hipFuncSetAttribute failed\n"); grid = -1; return; }
        if (hipOccupancyMaxActiveBlocksPerMultiprocessor(&per_cu, (const void*)fwd_kernel, NTHREADS, LDS_BYTES) != hipSuccess || per_cu < 1) fprintf(stderr, "kernel_launch: occupancy query reports %d\n", per_cu);
        (void)hipGetLastError();
        grid = cus;
        if (grid != 256) fprintf(stderr, "kernel_launch: note: %d CUs\n", grid);
    }
    if (grid < 0) return;
    (void)hipMemsetAsync((char*)d_ws + WS_CTL, 0, CTL_ZERO_BYTES, stream);
    Args a{};
    for (int i = 0; i < 18; ++i) a.in[i] = (const float*)d_in[i];
    a.out = (float*)d_out; a.ws = (unsigned char*)d_ws;
#if MK_PER_PHASE
    for (int p = 0; p < N_PHASES; ++p) { a.ph_lo = p; a.ph_hi = p + 1; hipLaunchKernelGGL(fwd_kernel, dim3(grid), dim3(NTHREADS), LDS_BYTES, stream, a); }
#else
    a.ph_lo = 0; a.ph_hi = N_PHASES;
    hipLaunchKernelGGL(fwd_kernel, dim3(grid), dim3(NTHREADS), LDS_BYTES, stream, a);
#endif
}
```

```cpp
#include <hip/hip_runtime.h>
#include <hip/hip_bf16.h>
#include <cstdio>
#include <cstdint>
#include <cmath>
namespace pg8 {
#define PG8_LAS __attribute__((address_space(3)))
typedef unsigned short bf16_t;
typedef short bf16x8 __attribute__((ext_vector_type(8)));
typedef float f32x4 __attribute__((ext_vector_type(4)));
typedef unsigned u32x4 __attribute__((ext_vector_type(4)));
constexpr int BM = 256, BK = 64, HALF = 128, HTB = HALF * BK * 2  , STAGE_BYTES = 8 * HTB, NXCD = 8, WGM = 8;

__host__ __device__ __forceinline__ int lds_byte(int r, int c) { const int st = (r >> 4) * 2 + (c >> 5), rr = r & 15, cc = c & 31, ob = rr * 64 + cc * 2; return st * 1024 + (ob ^ (((ob >> 9) & 1) << 5)); }
__host__ __device__ __forceinline__ void stage_rc(int b, int& R, int& C) { const int st = b / 1024, sb = b % 1024, swz = sb ^ (((sb >> 9) & 1) << 5); R = (st >> 1) * 16 + swz / 64; C = (st & 1) * 32 + (swz % 64) / 2; }
__host__ __device__ __forceinline__ int perm32(int rho) { const int n = rho >> 4, i = rho & 15; return 8 * (i >> 2) + 4 * n + (i & 3); }

struct Unit { int pm, pn; };
struct Gemm { const bf16_t* A; const bf16_t* Bt; int M, N, K; };

struct StaticOrder {
    int nM, nN, nwg, G, c;
    __host__ __device__ void init(int M, int N, int G_, int c_) { nM = M / BM; nN = N / BM; nwg = nM * nN; G = G_; c = c_; }
    __host__ __device__ bool next(int i, Unit& u) const {
        const long L = (long)i * G + c; if (L >= nwg) return false;
        int wgid = (int)L; { const int q = nwg / NXCD, r = nwg % NXCD, xcd = wgid % NXCD, off = wgid / NXCD; wgid = (xcd < r ? xcd * (q + 1) : r * (q + 1) + (xcd - r) * q) + off; }
        const int nig = WGM * nN, gid = wgid / nig, fm = gid * WGM, gsz = (nM - fm) < WGM ? (nM - fm) : WGM;
        u.pm = fm + ((wgid % nig) % gsz); u.pn = (wgid % nig) / gsz; return true;
    }
    __device__ __forceinline__ void a_ready(const Unit&) const {}
    __device__ __forceinline__ void done(const Unit&) const {}
};

__device__ __forceinline__ unsigned cvt_pk_bf16(float lo, float hi) { unsigned r; asm volatile("v_cvt_pk_bf16_f32 %0, %1, %2" : "=v"(r) : "v"(lo), "v"(hi)); return r; }
typedef float f32x2 __attribute__((ext_vector_type(2)));
typedef float f32x2 __attribute__((ext_vector_type(2)));
constexpr float QSCALE = 0.125f * 1.4426950408889634f;
__device__ __forceinline__ u32x4 pack8(f32x4 v0, f32x4 v1) { u32x4 w; w.x = cvt_pk_bf16(v0[0], v0[1]); w.y = cvt_pk_bf16(v0[2], v0[3]); w.z = cvt_pk_bf16(v1[0], v1[1]); w.w = cvt_pk_bf16(v1[2], v1[3]); return w; }
struct EpiFoxIn {
    static constexpr bool PERM = true, AFTER_DRAIN = false;
    bf16_t* Q; size_t qkv_stride; float* flogit;
    __device__ __forceinline__ void operator()(const f32x4 (&acc)[2][2][4][2], const Unit& u, int wr, int wc, int fr, int fq) const {
        const int row0 = u.pm * BM + wr * 64 + fr;
        if (u.pn < 12) {
            const int t = u.pn >> 2; bf16_t* base = Q + (size_t)t * qkv_stride; const float sc = t == 0 ? QSCALE : 1.f;
            const int col0 = (u.pn & 3) * BM + wc * 32 + 8 * fq;
#pragma unroll
            for (int ai = 0; ai < 2; ++ai)
#pragma unroll
                for (int m = 0; m < 4; ++m) { bf16_t* rowp = base + (size_t)(row0 + ai * HALF + m * 16) * 1024 + col0;
#pragma unroll
                    for (int bj = 0; bj < 2; ++bj) *(u32x4*)(rowp + bj * HALF) = pack8(acc[ai][bj][m][0] * sc, acc[ai][bj][m][1] * sc); }
        } else if (wc == 0 && fq < 2) {
#pragma unroll
            for (int ai = 0; ai < 2; ++ai)
#pragma unroll
                for (int m = 0; m < 4; ++m) { float* rowp = flogit + (size_t)(row0 + ai * HALF + m * 16) * 16 + 8 * fq;
                    *(f32x4*)(rowp) = acc[ai][0][m][0]; *(f32x4*)(rowp + 4) = acc[ai][0][m][1]; }
        }
    }
};
struct EpiNsaIn {
    static constexpr bool PERM = true, AFTER_DRAIN = false;
    bf16_t* Q; bf16_t* KV; size_t kv_stride; float* gates; const float* bgate;
    __device__ __forceinline__ void operator()(const f32x4 (&acc)[2][2][4][2], const Unit& u, int wr, int wc, int fr, int fq) const {
        const int row0 = u.pm * BM + wr * 64 + fr;
        if (u.pn < 4) {
            const int col0 = u.pn * BM + wc * 32 + 8 * fq;
#pragma unroll
            for (int ai = 0; ai < 2; ++ai)
#pragma unroll
                for (int m = 0; m < 4; ++m) { bf16_t* rowp = Q + (size_t)(row0 + ai * HALF + m * 16) * 1024 + col0;
#pragma unroll
                    for (int bj = 0; bj < 2; ++bj) *(u32x4*)(rowp + bj * HALF) = pack8(acc[ai][bj][m][0] * QSCALE, acc[ai][bj][m][1] * QSCALE); }
        } else if (u.pn < 10) {
            bf16_t* base = KV + (size_t)(u.pn - 4) * kv_stride; const int col0 = wc * 32 + 8 * fq;
#pragma unroll
            for (int ai = 0; ai < 2; ++ai)
#pragma unroll
                for (int m = 0; m < 4; ++m) { bf16_t* rowp = base + (size_t)(row0 + ai * HALF + m * 16) * 256 + col0;
#pragma unroll
                    for (int bj = 0; bj < 2; ++bj) *(u32x4*)(rowp + bj * HALF) = pack8(acc[ai][bj][m][0], acc[ai][bj][m][1]); }
        } else if (wc == 0 || (wc == 1 && fq < 2)) {
            const int lc = wc * 32 + 8 * fq;
            f32x4 b0 = *(const f32x4*)(bgate + lc), b1 = *(const f32x4*)(bgate + lc + 4);
#pragma unroll
            for (int ai = 0; ai < 2; ++ai)
#pragma unroll
                for (int m = 0; m < 4; ++m) { float* rowp = gates + (size_t)(row0 + ai * HALF + m * 16) * 48 + lc;
                    f32x4 v0 = acc[ai][0][m][0] + b0, v1 = acc[ai][0][m][1] + b1;
#pragma unroll
                    for (int i = 0; i < 4; ++i) { v0[i] = 1.f / (1.f + __expf(-v0[i])); v1[i] = 1.f / (1.f + __expf(-v1[i])); }
                    *(f32x4*)(rowp) = v0; *(f32x4*)(rowp + 4) = v1; }
        }
    }
};
struct EpiSwiGLU {
    static constexpr bool PERM = true, AFTER_DRAIN = false;
    bf16_t* U; int ldu;
    __device__ __forceinline__ void operator()(const f32x4 (&acc)[2][2][4][2], const Unit& u, int wr, int wc, int fr, int fq) const {
        const int row0 = u.pm * BM + wr * 64 + fr; const int col0 = u.pn * HALF + wc * 32 + 8 * fq;
#pragma unroll
        for (int ai = 0; ai < 2; ++ai)
#pragma unroll
            for (int m = 0; m < 4; ++m) { f32x4 r[2];
#pragma unroll
                for (int n = 0; n < 2; ++n) { const f32x4 a = acc[ai][0][m][n], b = acc[ai][1][m][n];
#pragma unroll
                    for (int i = 0; i < 4; ++i) r[n][i] = a[i] * b[i] / (1.f + __expf(-a[i])); }
                *(u32x4*)(U + (size_t)(row0 + ai * HALF + m * 16) * ldu + col0) = pack8(r[0], r[1]); }
    }
};
struct EpiResid {
    static constexpr bool PERM = false, AFTER_DRAIN = false;
    const float* xres; float* z; const float* gate; int gate_bstride; int rows_per_batch; float alpha;
    __device__ __forceinline__ void operator()(const f32x4 (&acc)[2][2][4][2], const Unit& u, int wr, int wc, int fr, int fq) const {
        const int b = (u.pm * BM) / rows_per_batch; const float* g = gate + (size_t)b * gate_bstride;
        const int col0 = u.pn * BM + wc * 32 + 4 * fq;
        f32x4 gv[2][2];
#pragma unroll
        for (int bj = 0; bj < 2; ++bj)
#pragma unroll
            for (int n = 0; n < 2; ++n) gv[bj][n] = *(const f32x4*)(g + col0 + bj * HALF + n * 16) + 1.0f;
#pragma unroll
        for (int ai = 0; ai < 2; ++ai)
#pragma unroll
            for (int m = 0; m < 4; ++m) { const size_t off = (size_t)(u.pm * BM + ai * HALF + wr * 64 + m * 16 + fr) * 1024 + col0;
#pragma unroll
                for (int bj = 0; bj < 2; ++bj)
#pragma unroll
                    for (int n = 0; n < 2; ++n) { const f32x4 xv = *(const f32x4*)(xres + off + bj * HALF + n * 16);
                        *(f32x4*)(z + off + bj * HALF + n * 16) = xv * alpha + gv[bj][n] * acc[ai][bj][m][n]; } }
    }
};
template <class Epi, class Sched, bool ALIGN_EPI = false, bool SP2 = false>
__device__ __forceinline__ void gemm_phase(PG8_LAS unsigned char* lds, const Gemm g, const Sched& S, const Epi& E) {
    const int tid = threadIdx.x, wid = __builtin_amdgcn_readfirstlane(tid >> 6), lane = tid & 63, wr = wid >> 2, wc = wid & 3, fr = lane & 15, fq = lane >> 4;
    const int K = g.K, nt = K / BK;
    unsigned voffA[2], voffB[2];
#pragma unroll
    for (int i = 0; i < 2; ++i) { int R, C; stage_rc(tid * 16 + i * 8192, R, C); const int Rb = Epi::PERM ? ((R & ~31) + perm32(R & 31)) : R;
        voffA[i] = (unsigned)(R * K + C) * 2u; voffB[i] = (unsigned)(Rb * K + C) * 2u; }
    const size_t kstep = (size_t)(BK * 2);
    const size_t hstep = (size_t)HALF * K * 2;
    const size_t tstep = 2 * hstep;
    const unsigned ldsw = (unsigned)wid * 1024u;
    const int aoff = lds_byte(wr * 64 + fr, fq * 8), boff = lds_byte(wc * 32 + fr, fq * 8);
#define PG8_SA(b, h) (((b) * 2 + (h)) * HTB)
#define PG8_SB(b, h) ((4 + (b) * 2 + (h)) * HTB)
#define PG8_STAGE(bufoff, gbase, voff) do { _Pragma("unroll") for (int _i = 0; _i < 2; ++_i) \
        __builtin_amdgcn_global_load_lds((const unsigned*)((const char*)(gbase) + (voff)[_i]), (PG8_LAS unsigned*)(lds + (bufoff) + ldsw + _i * 8192), 16, 0, 0); } while (0)
#define PG8_LDA(dst, b, h) do { _Pragma("unroll") for (int m = 0; m < 4; ++m) _Pragma("unroll") for (int k = 0; k < 2; ++k) dst[m][k] = *(const PG8_LAS bf16x8*)(lds + PG8_SA(b, h) + aoff + m * 2048 + k * 1024); } while (0)
#define PG8_LDB(dst, b, h) do { _Pragma("unroll") for (int n = 0; n < 2; ++n) _Pragma("unroll") for (int k = 0; k < 2; ++k) dst[n][k] = *(const PG8_LAS bf16x8*)(lds + PG8_SB(b, h) + boff + n * 2048 + k * 1024); } while (0)
#define PG8_MMA(ai, bj, At, Bt) do { __builtin_amdgcn_s_setprio(1); _Pragma("unroll") for (int m = 0; m < 4; ++m) _Pragma("unroll") for (int n = 0; n < 2; ++n) _Pragma("unroll") for (int k = 0; k < 2; ++k) \
        acc[ai][bj][m][n] = __builtin_amdgcn_mfma_f32_16x16x32_bf16(Bt[n][k], At[m][k], acc[ai][bj][m][n], 0, 0, 0); __builtin_amdgcn_s_setprio(0); } while (0)
#define PG8_WAIT_V(n) asm volatile("s_waitcnt vmcnt(" #n ")" ::: "memory")
#define PG8_WAIT_L(n) asm volatile("s_waitcnt lgkmcnt(" #n ")" ::: "memory")
#define PG8_BAR __builtin_amdgcn_s_barrier()
#define PG8_SCHED __builtin_amdgcn_sched_barrier(0)
    Unit cur, nxt; int ui = 0;
    if (!S.next(0, cur)) return;
    f32x4 acc[2][2][4][2];
#pragma unroll
    for (int a = 0; a < 2; ++a)
#pragma unroll
        for (int b = 0; b < 2; ++b)
#pragma unroll
            for (int m = 0; m < 4; ++m)
#pragma unroll
                for (int n = 0; n < 2; ++n) acc[a][b][m][n] = (f32x4){0.f, 0.f, 0.f, 0.f};
    bf16x8 At[4][2], B0[2][2], B1[2][2];
    const char* cA = (const char*)g.A + (size_t)cur.pm * tstep; const char* cB = (const char*)g.Bt + (size_t)cur.pn * tstep;
    S.a_ready(cur);
    if constexpr (SP2) {
        PG8_STAGE(PG8_SB(0, 0), cB, voffB); PG8_STAGE(PG8_SB(0, 1), cB + hstep, voffB); PG8_STAGE(PG8_SA(0, 0), cA, voffA); PG8_STAGE(PG8_SA(0, 1), cA + hstep, voffA);
        if (wr == 1) PG8_BAR;
        PG8_WAIT_V(2); PG8_BAR;
        PG8_STAGE(PG8_SB(1, 0), cB + kstep, voffB); PG8_STAGE(PG8_SA(1, 0), cA + kstep, voffA); PG8_STAGE(PG8_SB(1, 1), cB + hstep + kstep, voffB);
        PG8_WAIT_V(6); PG8_BAR;
    } else {
        PG8_STAGE(PG8_SB(0, 0), cB, voffB); PG8_STAGE(PG8_SA(0, 0), cA, voffA); PG8_STAGE(PG8_SB(0, 1), cB + hstep, voffB); PG8_STAGE(PG8_SA(0, 1), cA + hstep, voffA);
        if (wr == 1) PG8_BAR;
        PG8_WAIT_V(4); PG8_BAR;
        PG8_STAGE(PG8_SB(1, 0), cB + kstep, voffB); PG8_STAGE(PG8_SA(1, 0), cA + kstep, voffA); PG8_STAGE(PG8_SB(1, 1), cB + hstep + kstep, voffB);
        PG8_WAIT_V(6); PG8_BAR;
    }
    for (;;) {
        const bool has_next = S.next(ui + 1, nxt);
        const char* nA = has_next ? (const char*)g.A + (size_t)nxt.pm * tstep : cA; const char* nB = has_next ? (const char*)g.Bt + (size_t)nxt.pn * tstep : cB;
        for (int t = 0; t < nt; t += 2) {
            const bool last = (t == nt - 2);
            const char* a1 = cA + (size_t)(t + 1) * kstep;
            const char* a2 = last ? nA : cA + (size_t)(t + 2) * kstep; const char* b2 = last ? nB : cB + (size_t)(t + 2) * kstep;
            const char* a3 = a2 + kstep; const char* b3 = b2 + kstep;
            if (last && has_next) S.a_ready(nxt);
            if constexpr (SP2) {
            PG8_LDB(B0, 0, 0); PG8_LDB(B1, 0, 1); PG8_SCHED; PG8_LDA(At, 0, 0); PG8_STAGE(PG8_SA(1, 1), a1 + hstep, voffA);
            PG8_WAIT_V(8); PG8_WAIT_L(0); PG8_BAR; PG8_MMA(0, 0, At, B0); PG8_MMA(0, 1, At, B1); PG8_BAR; PG8_SCHED;
            PG8_LDA(At, 0, 1); PG8_STAGE(PG8_SB(0, 0), b2, voffB); PG8_STAGE(PG8_SB(0, 1), b2 + hstep, voffB); PG8_STAGE(PG8_SA(0, 0), a2, voffA);
            PG8_WAIT_V(8); PG8_WAIT_L(0); PG8_BAR; PG8_MMA(1, 0, At, B0); PG8_MMA(1, 1, At, B1); PG8_BAR; PG8_SCHED;
            PG8_LDB(B0, 1, 0); PG8_LDB(B1, 1, 1); PG8_SCHED; PG8_LDA(At, 1, 0); PG8_STAGE(PG8_SA(0, 1), a2 + hstep, voffA);
            PG8_WAIT_V(8); PG8_WAIT_L(0); PG8_BAR; PG8_MMA(0, 0, At, B0); PG8_MMA(0, 1, At, B1); PG8_BAR; PG8_SCHED;
            PG8_LDA(At, 1, 1); PG8_STAGE(PG8_SB(1, 0), b3, voffB); PG8_STAGE(PG8_SB(1, 1), b3 + hstep, voffB); PG8_STAGE(PG8_SA(1, 0), a3, voffA);
            PG8_WAIT_V(8); PG8_WAIT_L(0); PG8_BAR; PG8_MMA(1, 0, At, B0); PG8_MMA(1, 1, At, B1); PG8_BAR; PG8_SCHED;
            } else {
            PG8_LDB(B0, 0, 0); PG8_SCHED; PG8_LDA(At, 0, 0); PG8_STAGE(PG8_SA(1, 1), a1 + hstep, voffA);
            PG8_WAIT_L(8); PG8_BAR; PG8_WAIT_L(0); PG8_MMA(0, 0, At, B0); PG8_BAR; PG8_SCHED;
            PG8_LDB(B1, 0, 1); PG8_STAGE(PG8_SB(0, 0), b2, voffB);
            PG8_BAR; PG8_WAIT_L(0); PG8_MMA(0, 1, At, B1); PG8_BAR;
            PG8_LDA(At, 0, 1); PG8_STAGE(PG8_SA(0, 0), a2, voffA);
            PG8_BAR; PG8_WAIT_L(0); PG8_MMA(1, 0, At, B0); PG8_BAR; PG8_SCHED;
            PG8_STAGE(PG8_SB(0, 1), b2 + hstep, voffB);
            PG8_WAIT_V(6); PG8_BAR; PG8_MMA(1, 1, At, B1); PG8_BAR;
            PG8_LDB(B0, 1, 0); PG8_SCHED; PG8_LDA(At, 1, 0); PG8_STAGE(PG8_SA(0, 1), a2 + hstep, voffA);
            PG8_WAIT_L(8); PG8_BAR; PG8_WAIT_L(0); PG8_MMA(0, 0, At, B0); PG8_BAR; PG8_SCHED;
            PG8_LDB(B1, 1, 1); PG8_STAGE(PG8_SB(1, 0), b3, voffB);
            PG8_BAR; PG8_WAIT_L(0); PG8_MMA(0, 1, At, B1); PG8_BAR;
            PG8_LDA(At, 1, 1); PG8_STAGE(PG8_SA(1, 0), a3, voffA);
            PG8_BAR; PG8_WAIT_L(0); PG8_MMA(1, 0, At, B0); PG8_BAR; PG8_SCHED;
            PG8_STAGE(PG8_SB(1, 1), b3 + hstep, voffB);
            PG8_WAIT_V(6); PG8_BAR; PG8_MMA(1, 1, At, B1); PG8_BAR;
            }
        }
        if constexpr (ALIGN_EPI) { if (wr == 0) PG8_BAR; }
        if constexpr (!Epi::AFTER_DRAIN) { E(acc, cur, wr, wc, fr, fq); S.done(cur); }
        if (!has_next) break;
#pragma unroll
        for (int a = 0; a < 2; ++a)
#pragma unroll
            for (int b = 0; b < 2; ++b)
#pragma unroll
                for (int m = 0; m < 4; ++m)
#pragma unroll
                    for (int n = 0; n < 2; ++n) acc[a][b][m][n] = (f32x4){0.f, 0.f, 0.f, 0.f};
        cur = nxt; cA = nA; cB = nB; ++ui;
        if constexpr (ALIGN_EPI) { if (wr == 1) PG8_BAR; }
    }
    PG8_WAIT_V(0);
    if constexpr (!ALIGN_EPI) { if (wr == 0) PG8_BAR; }
    PG8_BAR;
    if constexpr (Epi::AFTER_DRAIN) { E.fused(acc, cur, wr, wc, fr, fq, lds, wid, lane); S.done(cur); }
#undef PG8_SA
#undef PG8_SB
#undef PG8_STAGE
#undef PG8_LDA
#undef PG8_LDB
#undef PG8_MMA
#undef PG8_WAIT_V
#undef PG8_WAIT_L
#undef PG8_BAR
#undef PG8_SCHED
}
}
#define GAS __attribute__((address_space(1)))
#define LAS __attribute__((address_space(3)))
typedef unsigned short bf16;
typedef unsigned v4u __attribute__((ext_vector_type(4)));
typedef float f32x4 __attribute__((ext_vector_type(4)));
typedef short bf16x8 __attribute__((ext_vector_type(8)));
typedef GAS unsigned gu32;
typedef GAS unsigned long long gu64;
#define RLX_AGENT __ATOMIC_RELAXED, __HIP_MEMORY_SCOPE_AGENT
#define LDS_WAIT() asm volatile("s_waitcnt lgkmcnt(0)" ::: "memory")
#define VM_WAIT() asm volatile("s_waitcnt vmcnt(0)" ::: "memory")
__device__ __forceinline__ unsigned long long rt() { return __builtin_amdgcn_s_memrealtime(); }
__device__ __forceinline__ unsigned f2bf(float f) { unsigned u = __builtin_bit_cast(unsigned, f); return (u + 0x7fffu + ((u >> 16) & 1u)) >> 16; }
__device__ __forceinline__ unsigned pk2(float lo, float hi) { return f2bf(lo) | (f2bf(hi) << 16); }

#define XB_TMO      128
#define XB_XCNT(j)  (256  + 64 * (j))
#define XB_XSUB(j)  (1280 + 64 * (j))
#define XB_XGEN(j)  (2304 + 64 * (j))
#define XB_TOP      3328
#define XB_TOPGEN   3392
#define XCD_BAR_WORDS 3456
#define XB_SPIN_CAP (1u << 18)

__device__ __forceinline__ unsigned xb_ld(unsigned* p)              { return __hip_atomic_load(p, __ATOMIC_RELAXED, __HIP_MEMORY_SCOPE_AGENT); }
__device__ __forceinline__ unsigned xb_add(unsigned* p, unsigned v) { return __hip_atomic_fetch_add(p, v, __ATOMIC_RELAXED, __HIP_MEMORY_SCOPE_AGENT); }
__device__ __forceinline__ unsigned xb_xcc_id() { return (unsigned)__builtin_amdgcn_s_getreg((3 << 11) | 20) & 0xFu; }
#define XB_SPIN(cond, bar) do { unsigned _sp = 0; while (cond) { __builtin_amdgcn_s_sleep(1); \
    if ((++_sp & 255u) == 0u) { if (xb_ld(&(bar)[XB_TMO])) break; if (_sp > XB_SPIN_CAP) { atomicAdd(&(bar)[XB_TMO], 1u); break; } } } } while (0)

struct XcdBarrier {
    unsigned* bar; unsigned x;
    volatile LAS unsigned* st;
};

__device__ __forceinline__ XcdBarrier xcd_barrier_post(unsigned* bar, volatile LAS unsigned* st) {
    XcdBarrier b; b.bar = bar; b.x = xb_xcc_id(); b.st = st;
    if (threadIdx.x == 0) (void)xb_add(&bar[XB_XCNT(b.x)], 1u);
    return b;
}
__device__ __forceinline__ void xcd_barrier_complete(unsigned* bar, unsigned x, unsigned& nloc, unsigned& nx) {
    const unsigned G = gridDim.x * gridDim.y * gridDim.z;
    unsigned sum, cnt, mine, sp = 0u;
    for (;;) {
        sum = 0u; cnt = 0u; mine = 0u;
#pragma unroll
        for (unsigned j = 0; j < 16; ++j) { const unsigned c = xb_ld(&bar[XB_XCNT(j)]); sum += c; cnt += (c > 0u) ? 1u : 0u; mine = (j == x) ? c : mine; }
        if (sum == G) break;
        __builtin_amdgcn_s_sleep(1);
        if ((++sp & 255u) == 0u) { if (xb_ld(&bar[XB_TMO])) break; if (sp > XB_SPIN_CAP) { atomicAdd(&bar[XB_TMO], 1u); break; } }
    }
    nloc = mine > 0u ? mine : 1u; nx = cnt > 0u ? cnt : 1u;
}

__device__ __forceinline__ void xcd_barrier(const XcdBarrier& b) {
    asm volatile("s_waitcnt vmcnt(0)" ::: "memory");
    __syncthreads();
    if (threadIdx.x == 0) {
        unsigned* bar = b.bar;
        __builtin_amdgcn_s_waitcnt(0);
        unsigned nloc = b.st[0], nx = b.st[1];
        if (nloc == 0u) { xcd_barrier_complete(bar, b.x, nloc, nx); b.st[0] = nloc; b.st[1] = nx; }
        const unsigned old = xb_add(&bar[XB_XSUB(b.x)], 1u);
        const unsigned gen = old / nloc;
        if (old + 1u == (gen + 1u) * nloc) {
            __builtin_amdgcn_fence(__ATOMIC_RELEASE, "agent");
            asm volatile("s_waitcnt vmcnt(0)" ::: "memory");
            const unsigned og = xb_add(&bar[XB_TOP], 1u);
            const unsigned tg = og / nx;
            if (og + 1u == (tg + 1u) * nx) xb_add(&bar[XB_TOPGEN], 1u);
            else XB_SPIN(xb_ld(&bar[XB_TOPGEN]) == tg, bar);
            __builtin_amdgcn_fence(__ATOMIC_ACQUIRE, "agent");
            xb_add(&bar[XB_XGEN(b.x)], 1u);
            asm volatile("s_waitcnt vmcnt(0)" ::: "memory");
        } else {
            XB_SPIN(xb_ld(&bar[XB_XGEN(b.x)]) == gen, bar);
            __builtin_amdgcn_fence(__ATOMIC_ACQUIRE, "agent");
            asm volatile("s_waitcnt vmcnt(0)" ::: "memory");
        }
    }
    __syncthreads();
}
constexpr int BATCH = 2, SEQ = 16384, DM = 1024, TOK = BATCH * SEQ;
constexpr int FF = 2816, NHEAD = 16, HD = 64, NGRP = 4;
constexpr int FOXN = 3088, FOXNP = 3328, NSAN = 2608, NSANP = 2816;
constexpr int NCMP = 1023, NCMPP = 1024, NSELB = 256;
constexpr float DN_ALPHA = 1.4142135623730951f, LN_EPS = 1e-5f, LOG2E = 1.4426950408889634f;
constexpr int NWAVES = 8, NTHREADS = 512;
constexpr int N_PHASES = 19;
#ifndef MK_PER_PHASE
#define MK_PER_PHASE 0
#endif
__device__ const unsigned char T5B[128] = {0, 1, 2, 3, 4, 5, 6, 7, 8, 9, 10, 11, 12, 13, 14, 15, 16, 16, 16, 17, 17, 18, 18, 18, 19, 19, 19, 20, 20, 20, 20, 21, 21, 21, 21, 22, 22, 22, 22, 22, 23, 23, 23, 23, 23, 23, 24, 24, 24, 24, 24, 24, 25, 25, 25, 25, 25, 25, 25, 26, 26, 26, 26, 26, 26, 26, 26, 27, 27, 27, 27, 27, 27, 27, 27, 27, 27, 28, 28, 28, 28, 28, 28, 28, 28, 28, 28, 29, 29, 29, 29, 29, 29, 29, 29, 29, 29, 29, 29, 30, 30, 30, 30, 30, 30, 30, 30, 30, 30, 30, 30, 30, 30, 31, 31, 31, 31, 31, 31, 31, 31, 31, 31, 31, 31, 31, 31, 31};
__device__ __forceinline__ int t5_bucket(int d) { return d >= 113 ? 31 : (int)T5B[d < 0 ? 0 : d]; }

constexpr size_t MiB = 1u << 20;
constexpr size_t WS_CTL = 0, CTL_ZERO_BYTES = 1 * MiB;
constexpr size_t WS_WFOXIN = 2 * MiB, WS_WFOXOUT = 9 * MiB, WS_WNSAIN = 11 * MiB, WS_WNSAOUT = 17 * MiB;
constexpr size_t WS_WFFIN0 = 19 * MiB, WS_WFFIN1 = 30 * MiB, WS_WFFOUT0 = 41 * MiB, WS_WFFOUT1 = 47 * MiB;
constexpr size_t WS_MOD = 53 * MiB;
constexpr size_t WS_CB1 = 53 * MiB + 512 * 1024;
constexpr size_t WS_FLOGIT = 54 * MiB;
constexpr size_t WS_G = 56 * MiB;
constexpr size_t WS_GATES = 58 * MiB;
constexpr size_t WS_KCMP = 64 * MiB, WS_VCMP = 65 * MiB;
constexpr size_t WS_SEL = 66 * MiB;
constexpr size_t WS_HBUF = 70 * MiB;
constexpr size_t WS_R = 134 * MiB;
constexpr size_t WS_OC = 326 * MiB;
constexpr size_t WS_KX = 454 * MiB;
constexpr size_t WS_END = 470 * MiB;
constexpr int CW_BAR = 4096;

constexpr int RING_BYTES = 131072, LDSCTL_OFF = RING_BYTES, MISC_OFF = LDSCTL_OFF + 320, LDS_BYTES = 147456;
__device__ __forceinline__ float bf2f(unsigned short u) { return __uint_as_float((unsigned)u << 16); }
__device__ __forceinline__ void bf8_to_f(const v4u w, float* o) {
    o[0] = __uint_as_float(w.x << 16); o[1] = __uint_as_float(w.x & 0xffff0000u); o[2] = __uint_as_float(w.y << 16); o[3] = __uint_as_float(w.y & 0xffff0000u);
    o[4] = __uint_as_float(w.z << 16); o[5] = __uint_as_float(w.z & 0xffff0000u); o[6] = __uint_as_float(w.w << 16); o[7] = __uint_as_float(w.w & 0xffff0000u);
}
__device__ __forceinline__ float wave_sum(float v) {
#pragma unroll
    for (int o = 1; o < 64; o <<= 1) v += __shfl_xor(v, o);
    return v;
}
__device__ __forceinline__ float wave_max(float v) {
#pragma unroll
    for (int o = 1; o < 64; o <<= 1) v = fmaxf(v, __shfl_xor(v, o));
    return v;
}
struct Ctx { int tid, lane, wave, vcu, G; unsigned char* lds; };

__device__ __forceinline__ void tr_item(const float* W, int ldw, int K, bf16* WT, int k0, int nd0, int sc0, int nvalid, float* scr, int lane) {
    const int col = lane & 31;
#pragma unroll 8
    for (int i = 0; i < 32; ++i) { const int kk = 2 * i + (lane >> 5); scr[kk * 33 + col] = col < nvalid ? W[(size_t)(k0 + kk) * ldw + sc0 + col] : 0.f; }
    LDS_WAIT(); asm volatile("" ::: "memory");
    const int c = lane & 7;
#pragma unroll
    for (int j = 0; j < 4; ++j) { const int n = (lane >> 3) + 8 * j; const float* s = scr + (8 * c) * 33 + n;
        v4u o; o.x = pk2(s[0 * 33], s[1 * 33]); o.y = pk2(s[2 * 33], s[3 * 33]); o.z = pk2(s[4 * 33], s[5 * 33]); o.w = pk2(s[6 * 33], s[7 * 33]);
        *(v4u*)(WT + (size_t)(nd0 + n) * K + k0 + 8 * c) = o; }
    LDS_WAIT(); asm volatile("" ::: "memory");
}
__device__ __forceinline__ void p_prep(const Ctx& C, const float* const* in, unsigned char* ws) {
    float* scr = (float*)(C.lds + C.wave * 16384);
    const int gw = C.vcu * NWAVES + C.wave, NGW = C.G * NWAVES;
    constexpr int I_FOXIN = 16 * (FOXNP / 32), I_SQ = 16 * 32, I_NSAIN = 16 * (NSANP / 32), I_FFIN = 16 * (2 * FF / 32), I_FFOUT = (FF / 64) * 32;
    constexpr int NITEMS = I_FOXIN + I_SQ + I_NSAIN + I_SQ + 2 * I_FFIN + 2 * I_FFOUT;
    for (int it = gw; it < NITEMS; it += NGW) {
        int r = it;
        if (r < I_FOXIN) { const int nb = r % (FOXNP / 32), kb = r / (FOXNP / 32); const int nd0 = 32 * nb; int nv = FOXN - nd0; nv = nv < 0 ? 0 : (nv > 32 ? 32 : nv);
            tr_item(in[6], FOXN, DM, (bf16*)(ws + WS_WFOXIN), 64 * kb, nd0, nd0, nv, scr, C.lane); continue; } r -= I_FOXIN;
        if (r < I_SQ) { const int nb = r % 32, kb = r / 32; tr_item(in[8], DM, DM, (bf16*)(ws + WS_WFOXOUT), 64 * kb, 32 * nb, 32 * nb, 32, scr, C.lane); continue; } r -= I_SQ;
        if (r < I_NSAIN) { const int nb = r % (NSANP / 32), kb = r / (NSANP / 32); const int nd0 = 32 * nb; int nv = NSAN - nd0; nv = nv < 0 ? 0 : (nv > 32 ? 32 : nv);
            tr_item(in[9], NSAN, DM, (bf16*)(ws + WS_WNSAIN), 64 * kb, nd0, nd0, nv, scr, C.lane); continue; } r -= I_NSAIN;
        if (r < I_SQ) { const int nb = r % 32, kb = r / 32; tr_item(in[14], DM, DM, (bf16*)(ws + WS_WNSAOUT), 64 * kb, 32 * nb, 32 * nb, 32, scr, C.lane); continue; } r -= I_SQ;
        if (r < 2 * I_FFIN) { const int l = r / I_FFIN; r -= l * I_FFIN; const int nb = r % (2 * FF / 32), kb = r / (2 * FF / 32); const int nd0 = 32 * nb, tile = nd0 >> 8, j = nd0 & 255;
            const int sc0 = j < 128 ? 128 * tile + j : FF + 128 * tile + (j - 128);
            tr_item(in[16] + (size_t)l * DM * 2 * FF, 2 * FF, DM, (bf16*)(ws + (l ? WS_WFFIN1 : WS_WFFIN0)), 64 * kb, nd0, sc0, 32, scr, C.lane); continue; } r -= 2 * I_FFIN;
        { const int l = r / I_FFOUT; r -= l * I_FFOUT; const int nb = r % 32, kb = r / 32;
            tr_item(in[17] + (size_t)l * FF * DM, DM, FF, (bf16*)(ws + (l ? WS_WFFOUT1 : WS_WFFOUT0)), 64 * kb, 32 * nb, 32 * nb, 32, scr, C.lane); }
    }
    __syncthreads();
    float* cs = (float*)C.lds;
    for (int i = C.tid; i < BATCH * DM; i += NTHREADS) { const float v = in[1][i]; cs[i] = v / (1.f + __expf(-v)); }
    __syncthreads();
    float* mod = (float*)(ws + WS_MOD);
    for (int o = blockIdx.x * NTHREADS + C.tid; o < 2 * BATCH * 6 * DM; o += C.G * NTHREADS) {
        const int col = o % (6 * DM), b = (o / (6 * DM)) % BATCH, l = o / (6 * DM * BATCH);
        const float* w = in[2] + (size_t)l * DM * 6 * DM + col; const float* cb = cs + b * DM;
        float acc = in[3][l * 6 * DM + col];
#pragma unroll 8
        for (int k = 0; k < DM; ++k) acc += cb[k] * w[(size_t)k * 6 * DM];
        mod[o] = acc;
    }
    float* cb1 = (float*)(ws + WS_CB1);
    for (int o = blockIdx.x * NTHREADS + C.tid; o < 2 * 128; o += C.G * NTHREADS) {
        const int kv = o >> 7, c = o & 127; const float* pos = in[11] + kv * 2048; const float* w1 = in[12] + (size_t)kv * 2048 * 128 + c;
        float acc = 0.f;
        for (int i = 0; i < 2048; ++i) acc += pos[i] * w1[(size_t)i * 128];
        cb1[o] = acc;
    }
    __syncthreads();
}

__device__ __forceinline__ void p_modrows(const Ctx& C, const float* x, const float* modl  , int sh_off, int sc_off, bf16* h) {
    const int gw = C.vcu * NWAVES + C.wave, NGW = C.G * NWAVES;
    for (int m = gw; m < TOK; m += NGW) {
        const int b = m / SEQ; const f32x4* xr = (const f32x4*)(x + (size_t)m * DM) + C.lane;
        const f32x4* sc = (const f32x4*)(modl + b * 6 * DM + sc_off) + C.lane; const f32x4* sh = (const f32x4*)(modl + b * 6 * DM + sh_off) + C.lane;
        unsigned long long* o8 = (unsigned long long*)(h + (size_t)m * DM) + C.lane;
#pragma unroll
        for (int j = 0; j < 4; ++j) { const f32x4 v = xr[64 * j] * (sc[64 * j] + 1.0f) + sh[64 * j];
            o8[64 * j] = (unsigned long long)pk2(v.x, v.y) | ((unsigned long long)pk2(v.z, v.w) << 32); }
    }
}
__device__ __forceinline__ void p_lnrows(const Ctx& C, float* xz, const float* lg, const float* lb, const float* modl, int sh_off, int sc_off, bf16* h) {
    const int gw = C.vcu * NWAVES + C.wave, NGW = C.G * NWAVES;
    for (int m = gw; m < TOK; m += NGW) {
        const int b = m / SEQ; f32x4* xr = (f32x4*)(xz + (size_t)m * DM) + C.lane;
        f32x4 v[4]; float s = 0.f;
#pragma unroll
        for (int j = 0; j < 4; ++j) { v[j] = xr[64 * j]; s += (v[j].x + v[j].y) + (v[j].z + v[j].w); }
        const float mean = wave_sum(s) * (1.f / DM); float s2 = 0.f;
#pragma unroll
        for (int j = 0; j < 4; ++j) { v[j] = v[j] - mean; s2 += (v[j].x * v[j].x + v[j].y * v[j].y) + (v[j].z * v[j].z + v[j].w * v[j].w); }
        const float rstd = 1.f / sqrtf(wave_sum(s2) * (1.f / DM) + LN_EPS);
#pragma unroll
        for (int j = 0; j < 4; ++j) { const f32x4 g = ((const f32x4*)lg)[C.lane + 64 * j], bb = ((const f32x4*)lb)[C.lane + 64 * j]; v[j] = v[j] * rstd * g + bb; xr[64 * j] = v[j]; }
        if (h) {
            const f32x4* sc = (const f32x4*)(modl + b * 6 * DM + sc_off) + C.lane; const f32x4* sh = (const f32x4*)(modl + b * 6 * DM + sh_off) + C.lane;
            unsigned long long* o8 = (unsigned long long*)(h + (size_t)m * DM) + C.lane;
#pragma unroll
            for (int j = 0; j < 4; ++j) { const f32x4 w = v[j] * (sc[64 * j] + 1.0f) + sh[64 * j];
                o8[64 * j] = (unsigned long long)pk2(w.x, w.y) | ((unsigned long long)pk2(w.z, w.w) << 32); }
        }
    }
}

__device__ __forceinline__ void p_scan(const Ctx& C, const float* flogit, const float* bf, float* Gf, bf16* KX) {
    const int gw = C.vcu * NWAVES + C.wave;
    if (gw >= BATCH * NHEAD) return;
    const int b = gw / NHEAD, h = gw % NHEAD; const float bias = bf[h];
    double carry = 0.0;
    for (int t0 = 0; t0 < SEQ; t0 += 64) {
        const float xv = flogit[(size_t)(b * SEQ + t0 + C.lane) * 16 + h] + bias;
        float ls = fminf(xv, 0.f) - log1pf(__expf(-fabsf(xv)));
        double v = (double)ls;
#pragma unroll
        for (int o = 1; o < 64; o <<= 1) { const double u = __shfl_up(v, o); if (C.lane >= o) v += u; }
        const double tot = __shfl(v, 63);
        const float gv = (float)((carry + v) * (double)LOG2E);
        Gf[(size_t)gw * SEQ + t0 + C.lane] = gv;
        { const float ng = -gv; const unsigned a0 = f2bf(ng); const float r1 = ng - __uint_as_float(a0 << 16); const unsigned a1 = f2bf(r1); const float r2 = r1 - __uint_as_float(a1 << 16); const unsigned a2 = f2bf(r2);
          v4u* kx = (v4u*)(KX + ((size_t)gw * SEQ + t0 + C.lane) * 16);
          v4u w; w.x = a0 | (a1 << 16); w.y = a2 | (0x3F80u << 16); w.z = 0x3F803F80u; w.w = 0u; kx[0] = w; kx[1] = (v4u){0u, 0u, 0u, 0u}; }
        carry += tot;
    }
}

__device__ __forceinline__ void p_fox_naive(const Ctx& C, const bf16* Q, const bf16* K, const bf16* V, const float* Gf, bf16* O) {
    float* Kt = (float*)C.lds; float* Vt = Kt + 4096; float* Gt = Vt + 4096;
    const int tid = C.tid;
    for (int u = C.vcu; u < 1024; u += C.G) {
        const int bh = u & 31, kk = u >> 5, s = kk & 7, it = kk >> 3;
        const int rb = it == 0 ? s : (it == 1 ? 15 - s : (it == 2 ? 16 + s : 31 - s));
        const int b = bh >> 4, h = bh & 15, row = rb * 512 + tid;
        float q[64], o[64];
        { const v4u* qp = (const v4u*)(Q + (size_t)(b * SEQ + row) * DM + h * HD);
#pragma unroll
          for (int i = 0; i < 8; ++i) bf8_to_f(qp[i], q + 8 * i); }
#pragma unroll
        for (int i = 0; i < 64; ++i) o[i] = 0.f;
        const float gi = Gf[(size_t)bh * SEQ + row];
        float m = -INFINITY, l = 0.f;
        const int jend = (rb + 1) * 512;
        for (int j0 = 0; j0 < jend; j0 += 64) {
            __syncthreads();
            { const int key = tid >> 3, ch = tid & 7; const size_t off = (size_t)(b * SEQ + j0 + key) * DM + h * HD + ch * 8;
              float t8[8]; bf8_to_f(*(const v4u*)(K + off), t8);
              *(f32x4*)(Kt + key * 64 + ch * 8) = (f32x4){t8[0], t8[1], t8[2], t8[3]}; *(f32x4*)(Kt + key * 64 + ch * 8 + 4) = (f32x4){t8[4], t8[5], t8[6], t8[7]};
              bf8_to_f(*(const v4u*)(V + off), t8);
              *(f32x4*)(Vt + key * 64 + ch * 8) = (f32x4){t8[0], t8[1], t8[2], t8[3]}; *(f32x4*)(Vt + key * 64 + ch * 8 + 4) = (f32x4){t8[4], t8[5], t8[6], t8[7]};
              if (tid < 64) Gt[tid] = Gf[(size_t)bh * SEQ + j0 + tid]; }
            __syncthreads();
            if (j0 > row) continue;
            const int kmax = (row - j0) < 63 ? (row - j0) : 63;
            for (int key = 0; key <= kmax; ++key) {
                const f32x4* kr = (const f32x4*)(Kt + key * 64);
                float d0 = 0.f, d1 = 0.f, d2 = 0.f, d3 = 0.f;
#pragma unroll
                for (int i = 0; i < 16; ++i) { const f32x4 kv = kr[i]; d0 += q[4 * i] * kv.x; d1 += q[4 * i + 1] * kv.y; d2 += q[4 * i + 2] * kv.z; d3 += q[4 * i + 3] * kv.w; }
                const float sv = ((d0 + d1) + (d2 + d3)) + (gi - Gt[key]);
                if (sv > m) { const float f = exp2f(m - sv); l *= f;
#pragma unroll
                    for (int i = 0; i < 64; ++i) o[i] *= f;
                    m = sv; }
                const float p = exp2f(sv - m); l += p;
                const f32x4* vr = (const f32x4*)(Vt + key * 64);
#pragma unroll
                for (int i = 0; i < 16; ++i) { const f32x4 vv = vr[i]; o[4 * i] += p * vv.x; o[4 * i + 1] += p * vv.y; o[4 * i + 2] += p * vv.z; o[4 * i + 3] += p * vv.w; }
            }
        }
        const float rl = 1.f / l;
        v4u* op = (v4u*)(O + (size_t)(b * SEQ + row) * DM + h * HD);
#pragma unroll
        for (int i = 0; i < 8; ++i) { v4u w; w.x = pk2(o[8 * i] * rl, o[8 * i + 1] * rl); w.y = pk2(o[8 * i + 2] * rl, o[8 * i + 3] * rl); w.z = pk2(o[8 * i + 4] * rl, o[8 * i + 5] * rl); w.w = pk2(o[8 * i + 6] * rl, o[8 * i + 7] * rl); op[i] = w; }
    }
    __syncthreads();
}

__device__ __forceinline__ void p_compress_naive(const Ctx& C, const bf16* KV  , size_t kv_stride, const float* w1a, const float* w2a, const float* cb1, bf16* kcmp, bf16* vcmp) {
    const int gw = C.vcu * NWAVES + C.wave, NGW = C.G * NWAVES;
    float* hid = (float*)(C.lds + C.wave * 4096);
    for (int u = gw; u < 2 * BATCH * NGRP * 256; u += NGW) {
        const int nq = u & 255, g = (u >> 8) & 3, b = (u >> 10) & 1, kv = u >> 11;
        const bf16* src = KV + (size_t)kv * kv_stride + (size_t)b * SEQ * 256 + g * 64;
        const float* w1 = w1a + (size_t)kv * 2048 * 128; const float* w2 = w2a + (size_t)kv * 128 * 64;
        float a0[4], a1[4];
#pragma unroll
        for (int j = 0; j < 4; ++j) { a0[j] = cb1[kv * 128 + C.lane]; a1[j] = cb1[kv * 128 + 64 + C.lane]; }
        const int n0 = nq * 4;
        for (int i = 0; i < 2048; ++i) {
            const float wa = w1[(size_t)i * 128 + C.lane], wb = w1[(size_t)i * 128 + 64 + C.lane];
#pragma unroll
            for (int j = 0; j < 4; ++j) { const int n = n0 + j; const int tok = 16 * n + (i >> 6);
                const float xv = (n < NCMP) ? bf2f(src[(size_t)tok * 256 + (i & 63)]) : 0.f;
                a0[j] += xv * wa; a1[j] += xv * wb; }
        }
#pragma unroll
        for (int j = 0; j < 4; ++j) { hid[j * 128 + C.lane] = a0[j] / (1.f + __expf(-a0[j])); hid[j * 128 + 64 + C.lane] = a1[j] / (1.f + __expf(-a1[j])); }
        LDS_WAIT(); asm volatile("" ::: "memory");
        float oo[4] = {0.f, 0.f, 0.f, 0.f};
        for (int c = 0; c < 128; ++c) { const float w = w2[c * 64 + C.lane];
#pragma unroll
            for (int j = 0; j < 4; ++j) oo[j] += hid[j * 128 + c] * w; }
        bf16* dst = (kv ? vcmp : kcmp) + (size_t)((b * NGRP + g) * NCMPP) * 64;
#pragma unroll
        for (int j = 0; j < 4; ++j) { const int n = n0 + j; dst[(size_t)n * 64 + C.lane] = (n < NCMP) ? (bf16)f2bf(oo[j]) : (bf16)0; }
        LDS_WAIT(); asm volatile("" ::: "memory");
    }
}

template <int MODE  >
__device__ __forceinline__ void wave_attn(const float (&q)[64], int t, int nchunks, int nvis, const int* bl, const bf16* Kb, const bf16* Vb, int pitch, const float* relh  ,
                                          float* sc, float& l_out, float& o_out, int lane) {
    float mx = -INFINITY;
    for (int c = 0; c < nchunks; ++c) {
        const int slot = 64 * c + lane; int key, dist; bool valid;
        if (MODE == 0) { key = slot; valid = slot < nvis; dist = t - (16 * slot + 31); }
        else if (MODE == 1) { key = 64 * bl[c] + lane; valid = key <= t; dist = t - key; }
        else { key = t - 511 + slot; valid = key >= 0; dist = t - key; }
        float s = -INFINITY;
        if (valid) {
            const v4u* kp = (const v4u*)(Kb + (size_t)key * pitch); float d0 = 0.f, d1 = 0.f;
#pragma unroll
            for (int i = 0; i < 8; ++i) { float k8[8]; bf8_to_f(kp[i], k8);
#pragma unroll
                for (int e = 0; e < 8; e += 2) { d0 += q[8 * i + e] * k8[e]; d1 += q[8 * i + e + 1] * k8[e + 1]; } }
            s = (d0 + d1) + relh[16 * t5_bucket(dist)] * LOG2E;
        }
        sc[slot] = s; mx = fmaxf(mx, s);
    }
    mx = wave_max(mx);
    float ls = 0.f;
    if (mx == -INFINITY) { l_out = 0.f; o_out = 0.f; for (int c = 0; c < nchunks; ++c) sc[64 * c + lane] = 0.f; LDS_WAIT(); return; }
    for (int c = 0; c < nchunks; ++c) { const int slot = 64 * c + lane; const float s = sc[slot]; const float p = (s == -INFINITY) ? 0.f : exp2f(s - mx); sc[slot] = p; ls += p; }
    l_out = wave_sum(ls);
    LDS_WAIT(); asm volatile("" ::: "memory");
    float o = 0.f;
    const int ntot = (MODE == 0) ? nvis : 64 * nchunks;
    for (int slot = 0; slot < ntot; ++slot) {
        const float p = sc[slot];
        if (p != 0.f) { int key; if (MODE == 0) key = slot; else if (MODE == 1) key = 64 * bl[slot >> 6] + (slot & 63); else key = t - 511 + slot;
            o += p * bf2f(Vb[(size_t)key * pitch + lane]); }
    }
    o_out = o;
}
__device__ __forceinline__ void load_q(const bf16* Qrow, float* qs, float (&q)[64], int lane) {
    qs[lane] = bf2f(Qrow[lane]); LDS_WAIT(); asm volatile("" ::: "memory");
#pragma unroll
    for (int i = 0; i < 16; ++i) { const f32x4 v = ((const f32x4*)qs)[i]; q[4 * i] = v.x; q[4 * i + 1] = v.y; q[4 * i + 2] = v.z; q[4 * i + 3] = v.w; }
    asm volatile("" ::: "memory");
}
__device__ __forceinline__ void p_nsa_cmp_naive(const Ctx& C, const bf16* Q, const bf16* kcmp, const bf16* vcmp, const float* relb, float* OC, unsigned* SEL) {
    const int gw = C.vcu * NWAVES + C.wave, NGW = C.G * NWAVES, lane = C.lane;
    float* sc = (float*)(C.lds + C.wave * 10240); float* imp = sc + 1024; float* qs = imp + 1024;
    for (int u = gw; u < TOK * NGRP; u += NGW) {
        const int g = u & 3, tok = u >> 2, b = tok / SEQ, t = tok % SEQ;
        int nvis = t >= 31 ? ((t - 31) / 16 + 1) : 0; if (nvis > NCMP) nvis = NCMP;
        const int nch = (nvis + 63) >> 6;
        for (int i = lane; i < 1024; i += 64) imp[i] = 0.f;
        const bf16* Kb = kcmp + (size_t)((b * NGRP + g) * NCMPP) * 64; const bf16* Vb = vcmp + (size_t)((b * NGRP + g) * NCMPP) * 64;
        for (int hh = 0; hh < 4; ++hh) {
            const int head = g * 4 + hh; float q[64];
            load_q(Q + (size_t)tok * DM + head * HD, qs, q, lane);
            float l, o;
            wave_attn<0>(q, t, nch, nvis, nullptr, Kb, Vb, 64, relb + head, sc, l, o, lane);
            const float rl = l > 0.f ? 1.f / fmaxf(l, 1e-30f) : 0.f;
            OC[(size_t)tok * DM + head * HD + lane] = o * rl;
            for (int c = 0; c < nch; ++c) imp[64 * c + lane] += sc[64 * c + lane] * rl;
            LDS_WAIT(); asm volatile("" ::: "memory");
        }
        const int cur = t >> 6;
        float val[4];
#pragma unroll
        for (int k = 0; k < 4; ++k) { const int j = lane + 64 * k; float v = 0.f;
#pragma unroll
            for (int a = -1; a <= 3; ++a) { const int idx = 4 * j + a; if (idx >= 0 && idx < nvis) v += imp[idx]; }
            const bool forced = (j == 0) || (j == cur) || (j == cur - 1);
            val[k] = forced ? 1e9f : (j <= cur ? v : -1e30f); }
        unsigned mw[8];
#pragma unroll
        for (int w = 0; w < 8; ++w) mw[w] = 0u;
        for (int r = 0; r < 16; ++r) {
            float bv = val[0]; int bj = lane;
#pragma unroll
            for (int k = 1; k < 4; ++k) if (val[k] > bv) { bv = val[k]; bj = lane + 64 * k; }
#pragma unroll
            for (int o = 1; o < 64; o <<= 1) { const float ov = __shfl_xor(bv, o); const int oj = __shfl_xor(bj, o); if (ov > bv || (ov == bv && oj < bj)) { bv = ov; bj = oj; } }
            if (bv > -0.5e30f) {
#pragma unroll
                for (int w = 0; w < 8; ++w) mw[w] |= (w == (bj >> 5)) ? (1u << (bj & 31)) : 0u;
            }
            if ((bj & 63) == lane) {
#pragma unroll
                for (int k = 0; k < 4; ++k) if (k == (bj >> 6)) val[k] = -3e38f;
            }
        }
        if (lane < 8) { unsigned w = mw[0];
#pragma unroll
            for (int k = 1; k < 8; ++k) if (lane == k) w = mw[k];
            SEL[(size_t)u * 8 + lane] = w; }
    }
}
__device__ __forceinline__ void p_nsa_selwin_naive(const Ctx& C, const bf16* Q, const bf16* KVb, size_t kv_stride, const float* relb, const float* OC, const unsigned* SEL, const float* gates, bf16* O) {
    const int gw = C.vcu * NWAVES + C.wave, NGW = C.G * NWAVES, lane = C.lane;
    float* sc = (float*)(C.lds + C.wave * 10240); int* bl = (int*)(sc + 1024); float* qs = sc + 1024 + 64;
    const bf16* KS = KVb + 2 * kv_stride; const bf16* VS = KVb + 3 * kv_stride; const bf16* KW = KVb + 4 * kv_stride; const bf16* VW = KVb + 5 * kv_stride;
    for (int u = gw; u < TOK * NGRP; u += NGW) {
        const int g = u & 3, tok = u >> 2, b = tok / SEQ, t = tok % SEQ;
        int nsel = 0;
        for (int w = 0; w < 8; ++w) { unsigned mwv = SEL[(size_t)u * 8 + w]; while (mwv) { const int bit = __builtin_ctz(mwv); mwv &= mwv - 1; if (lane == 0) bl[nsel] = 32 * w + bit; ++nsel; } }
        LDS_WAIT(); asm volatile("" ::: "memory");
        const size_t boff = (size_t)b * SEQ * 256 + g * 64;
        for (int hh = 0; hh < 4; ++hh) {
            const int head = g * 4 + hh; float q[64];
            load_q(Q + (size_t)tok * DM + head * HD, qs, q, lane);
            float ls, os, lw, ow;
            wave_attn<1>(q, t, nsel, 0, bl, KS + boff, VS + boff, 256, relb + head, sc, ls, os, lane);
            LDS_WAIT(); asm volatile("" ::: "memory");
            wave_attn<2>(q, t, 8, 0, nullptr, KW + boff, VW + boff, 256, relb + head, sc, lw, ow, lane);
            LDS_WAIT(); asm volatile("" ::: "memory");
            const float* gt = gates + (size_t)tok * 48;
            const float oc = OC[(size_t)tok * DM + head * HD + lane];
            const float outv = gt[head] * oc + gt[16 + head] * (os / fmaxf(ls, 1e-30f)) + gt[32 + head] * (ow / fmaxf(lw, 1e-30f));
            O[(size_t)tok * DM + head * HD + lane] = (bf16)f2bf(outv);
        }
    }
}
namespace fa {
using bf16x8 = __attribute__((ext_vector_type(8))) short;
using s16x4 = __attribute__((ext_vector_type(4))) short;
using f32x16 = __attribute__((ext_vector_type(16))) float;
using u32x4 = __attribute__((ext_vector_type(4))) unsigned;
typedef __attribute__((address_space(3))) const char* lds_cptr;
constexpr int SLOTB = 8192, KXSLOT = 2048;
constexpr int L_K = 0, L_V = 3 * SLOTB, L_KX = 6 * SLOTB, L_WS = L_KX + 3 * KXSLOT, L_OST = L_WS + 8 * 256, L_END = L_OST + 8 * 4096;
#define FA_SBAR() __builtin_amdgcn_sched_barrier(0)
#define FA_MFMA(a, b, c) __builtin_amdgcn_mfma_f32_32x32x16_bf16(a, b, c, 0, 0, 0)
#define FA_WAIT_BAR(N) asm volatile("s_waitcnt vmcnt(" #N ") lgkmcnt(0)\n\ts_barrier" ::: "memory")
__device__ __forceinline__ int crow(int r, int hi) { return (r & 3) + 8 * (r >> 2) + 4 * hi; }
__device__ __forceinline__ void glds16(const void* g, unsigned lds_dst) { unsigned keep;
    asm volatile("s_mov_b32 %0, m0\n\ts_mov_b32 m0, %2\n\ts_nop 0\n\tglobal_load_lds_dwordx4 %1, off\n\ts_mov_b32 m0, %0" : "=&s"(keep) : "v"(g), "s"(lds_dst) : "memory"); }
__device__ __forceinline__ void glds4(const void* g, unsigned lds_dst) { unsigned keep;
    asm volatile("s_mov_b32 %0, m0\n\ts_mov_b32 m0, %2\n\ts_nop 0\n\tglobal_load_lds_dword %1, off\n\ts_mov_b32 m0, %0" : "=&s"(keep) : "v"(g), "s"(lds_dst) : "memory"); }
typedef float f32x2_t __attribute__((ext_vector_type(2))); typedef __bf16 bf16x2_t __attribute__((ext_vector_type(2)));
__device__ __forceinline__ unsigned cvtpk(float lo, float hi) { f32x2_t v = {lo, hi}; bf16x2_t b = __builtin_convertvector(v, bf16x2_t); return __builtin_bit_cast(unsigned, b); }
#define FA_MX3(a, b, c) __builtin_fmaxf(__builtin_fmaxf((a), (b)), (c))
__device__ __forceinline__ float rowmax(const f32x16& p0, const f32x16& p1) {
    float a = FA_MX3(p0[0], p0[1], p1[0]), b = FA_MX3(p0[2], p0[3], p1[1]); a = FA_MX3(a, p1[2], p1[3]);
#pragma unroll
    for (int r = 4; r < 16; r += 4) { a = FA_MX3(a, p0[r], p0[r + 1]); b = FA_MX3(b, p0[r + 2], p0[r + 3]); a = FA_MX3(a, p1[r], p1[r + 1]); b = FA_MX3(b, p1[r + 2], p1[r + 3]); }
    float m = __builtin_fmaxf(a, b); auto rr = __builtin_amdgcn_permlane32_swap(__float_as_uint(m), __float_as_uint(m), false, false);
    return __builtin_fmaxf(__uint_as_float(rr[0]), __uint_as_float(rr[1])); }
__device__ __forceinline__ void qkt_acc(f32x16& p0, f32x16& p1, lds_cptr kp, const bf16x8* qr) {
#pragma unroll
    for (int d0 = 0; d0 < 4; ++d0) {
        const bf16x8 b0 = *(const __attribute__((address_space(3))) bf16x8*)(kp + d0 * 2048);
        const bf16x8 b1 = *(const __attribute__((address_space(3))) bf16x8*)(kp + d0 * 2048 + 512);
        p0 = FA_MFMA(b0, qr[d0], p0); p1 = FA_MFMA(b1, qr[d0], p1); }
}
__device__ __forceinline__ void pv(f32x16* o, int vb, bf16x8 pa0, bf16x8 pa1, bf16x8 pa2, bf16x8 pa3) {
#pragma unroll
    for (int d0 = 0; d0 < 2; ++d0) { s16x4 lo[4], hi[4];
#pragma unroll
        for (int ks = 0; ks < 4; ++ks) {
            asm volatile("ds_read_b64_tr_b16 %0,%1 offset:%c2" : "=&v"(lo[ks]) : "v"(vb), "i"(d0 * 4096 + ks * 1024) : "memory");
            asm volatile("ds_read_b64_tr_b16 %0,%1 offset:%c2" : "=&v"(hi[ks]) : "v"(vb), "i"(d0 * 4096 + ks * 1024 + 512) : "memory"); }
        asm volatile("s_waitcnt lgkmcnt(0)" ::: "memory"); FA_SBAR();
#define FA_PK(k) (bf16x8){lo[k][0], lo[k][1], lo[k][2], lo[k][3], hi[k][0], hi[k][1], hi[k][2], hi[k][3]}
        o[d0] = FA_MFMA(pa0, FA_PK(0), o[d0]); o[d0] = FA_MFMA(pa1, FA_PK(1), o[d0]); o[d0] = FA_MFMA(pa2, FA_PK(2), o[d0]); o[d0] = FA_MFMA(pa3, FA_PK(3), o[d0]);
#undef FA_PK
    }
}
template <int THRL>
__device__ __forceinline__ void softmax_pv(f32x16& p0, f32x16& p1, f32x16* o, float& mhat, float& l_reg, bool& moved, float* wsf, int vb, int r32, int hi) {
    const float rm = rowmax(p0, p1);
    moved = false;
    if (__any(rm > (float)THRL)) {
        const float dl = __builtin_fmaxf(rm, 0.f); mhat += dl;
#pragma unroll
        for (int r = 0; r < 16; ++r) { p0[r] -= dl; p1[r] -= dl; }
        const float f = __builtin_amdgcn_exp2f(-dl); l_reg *= f; if (hi == 0) wsf[r32] = f;
        asm volatile("s_waitcnt lgkmcnt(0)" ::: "memory");
#pragma unroll
        for (int d = 0; d < 2; ++d)
#pragma unroll
            for (int r = 0; r < 16; ++r) o[d][r] *= wsf[crow(r, hi)];
        moved = true;
    }
    float s0 = 0.f, s1 = 0.f;
#pragma unroll
    for (int r = 0; r < 16; ++r) { p0[r] = __builtin_amdgcn_exp2f(p0[r]); p1[r] = __builtin_amdgcn_exp2f(p1[r]); s0 += p0[r]; s1 += p1[r]; }
    l_reg += s0 + s1;
    u32x4 pw0 = {cvtpk(p0[0], p0[1]), cvtpk(p0[2], p0[3]), cvtpk(p0[4], p0[5]), cvtpk(p0[6], p0[7])};
    u32x4 pw1 = {cvtpk(p0[8], p0[9]), cvtpk(p0[10], p0[11]), cvtpk(p0[12], p0[13]), cvtpk(p0[14], p0[15])};
    u32x4 pw2 = {cvtpk(p1[0], p1[1]), cvtpk(p1[2], p1[3]), cvtpk(p1[4], p1[5]), cvtpk(p1[6], p1[7])};
    u32x4 pw3 = {cvtpk(p1[8], p1[9]), cvtpk(p1[10], p1[11]), cvtpk(p1[12], p1[13]), cvtpk(p1[14], p1[15])};
    FA_SBAR();
    pv(o, vb, __builtin_bit_cast(bf16x8, pw0), __builtin_bit_cast(bf16x8, pw1), __builtin_bit_cast(bf16x8, pw2), __builtin_bit_cast(bf16x8, pw3));
}
__device__ __forceinline__ unsigned short bfr(float x) { unsigned u = __float_as_uint(x); return (unsigned short)((u + 0x7fffu + ((u >> 16) & 1u)) >> 16); }
__device__ __forceinline__ float bfv(unsigned short h) { return __uint_as_float((unsigned)h << 16); }
__device__ __forceinline__ void split3(float x, unsigned short& a, unsigned short& b, unsigned short& c) { a = bfr(x); const float r1 = x - bfv(a); b = bfr(r1); c = bfr(r1 - bfv(b)); }

template <int THRL>
__device__ __forceinline__ void fox_unit(int b, int h, int qb, const bf16* Q, const bf16* __restrict__ K, const bf16* __restrict__ V, const bf16* __restrict__ KX, const float* __restrict__ Gf, bf16* O, char* shm) {
    int tid = threadIdx.x; asm volatile("" : "+v"(tid));
    const int lane = tid & 63, r32 = lane & 31, hi = lane >> 5; const int wid = __builtin_amdgcn_readfirstlane(tid >> 6);
    const long rowbase = (long)b * SEQ; const int q0 = qb * 256, NT = 4 * qb + 4;
    const bf16* Qw = Q + (rowbase + q0 + wid * 32) * DM + h * HD;
    const bf16* Kh = K + rowbase * DM + h * HD; const bf16* Vh = V + rowbase * DM + h * HD;
    const float* Gh = Gf + (size_t)(b * NHEAD + h) * SEQ;
    const char* KXh = (const char*)(KX + (size_t)(b * NHEAD + h) * SEQ * 16);
    const unsigned lds0 = (unsigned)(uintptr_t)shm; float* wsf = (float*)(shm + L_WS) + wid * 64;
    const bf16* ksrc = Kh + (long)lane * DM + wid * 8;
    const bf16* vsrc = Vh + (long)(16 * (wid & 3) + (lane >> 2)) * DM + (wid >> 2) * 32 + (lane & 3) * 8;
    const char* xsrc = KXh + wid * 256 + lane * 4;
    const unsigned kdst = lds0 + L_K + wid * 1024, vdst = lds0 + L_V + wid * 1024, xdst = lds0 + L_KX + wid * 256;
#define DMA_T(t, sl) do { glds16(ksrc + (long)(t) * 64 * DM, (unsigned)__builtin_amdgcn_readfirstlane(kdst + (sl) * SLOTB)); \
                          glds16(vsrc + (long)(t) * 64 * DM, (unsigned)__builtin_amdgcn_readfirstlane(vdst + (sl) * SLOTB)); \
                          glds4(xsrc + (long)(t) * 2048, (unsigned)__builtin_amdgcn_readfirstlane(xdst + (sl) * KXSLOT)); } while (0)
    const int vb0 = (int)(lds0 + L_V) + ((lane >> 4) & 1) * 32 + (lane & 3) * 8 + (4 * hi + ((lane & 15) >> 2)) * 64;
    const lds_cptr shm3 = (lds_cptr)shm; const lds_cptr kp0 = shm3 + L_K + hi * 1024 + r32 * 16; const lds_cptr xp0 = shm3 + L_KX + r32 * 32 + hi * 16;
    DMA_T(0, 0); DMA_T(1, 1);
    bf16x8 qr[4];
#pragma unroll
    for (int d0 = 0; d0 < 4; ++d0) qr[d0] = *reinterpret_cast<const bf16x8*>(&Qw[(long)r32 * DM + d0 * 16 + hi * 8]);
    const float anchor = Gh[q0]; const float gi_rel = Gh[q0 + wid * 32 + r32] - anchor;
    bf16x8 qx;
    { unsigned short a0, a1, a2; split3(anchor, a0, a1, a2); const short one = (short)0x3F80;
      qx = (bf16x8){one, one, one, (short)a0, (short)a1, (short)a2, 0, 0}; if (hi) qx = (bf16x8){0, 0, 0, 0, 0, 0, 0, 0}; }
    float mhat = 0.f, l_reg = 0.f; f32x16 o[2]; o[0] = f32x16{}; o[1] = f32x16{};
    const int qrel = wid * 32 + r32;
    int sl = 0;
    for (int t = 0; t < NT; ++t) {
        if (t + 1 < NT) { FA_WAIT_BAR(3); } else { FA_WAIT_BAR(0); }
        if (t + 2 < NT) { const int s2 = sl >= 1 ? sl - 1 : 2; DMA_T(t + 2, s2); }
        f32x16 p0, p1; const float c0 = gi_rel - mhat;
#pragma unroll
        for (int r = 0; r < 16; ++r) { p0[r] = c0; p1[r] = c0; }
        { const bf16x8 x0 = *(const __attribute__((address_space(3))) bf16x8*)(xp0 + sl * KXSLOT); const bf16x8 x1 = *(const __attribute__((address_space(3))) bf16x8*)(xp0 + sl * KXSLOT + 1024);
          p0 = FA_MFMA(x0, qx, p0); p1 = FA_MFMA(x1, qx, p1); }
        qkt_acc(p0, p1, kp0 + sl * SLOTB, qr);
        { const int jb = t - (NT - 4);
          if (jb >= 0) { const int kb = 64 * jb + 4 * hi;
#pragma unroll
              for (int r = 0; r < 16; ++r) { const int kv = kb + (r & 3) + 8 * (r >> 2); if (kv > qrel) p0[r] = -INFINITY; if (kv + 32 > qrel) p1[r] = -INFINITY; } } }
        bool moved;
        softmax_pv<THRL>(p0, p1, o, mhat, l_reg, moved, wsf, vb0 + sl * SLOTB, r32, hi);
        sl = sl == 2 ? 0 : sl + 1;
    }
    { auto rr = __builtin_amdgcn_permlane32_swap(__float_as_uint(l_reg), __float_as_uint(l_reg), false, false); l_reg = __uint_as_float(rr[0]) + __uint_as_float(rr[1]); }
    if (hi == 0) wsf[32 + r32] = l_reg; asm volatile("s_waitcnt lgkmcnt(0)" ::: "memory");
    float rli[16];
#pragma unroll
    for (int r = 0; r < 16; ++r) rli[r] = __builtin_amdgcn_rcpf(wsf[32 + crow(r, hi)]);
    bf16* Ow = O + (rowbase + q0 + wid * 32) * DM + h * HD;
    { unsigned short* stg = (unsigned short*)(shm + L_OST) + wid * 2048;
#pragma unroll
      for (int r = 0; r < 16; ++r) { const int orow = crow(r, hi);
#pragma unroll
          for (int d0 = 0; d0 < 2; ++d0) stg[orow * 64 + d0 * 32 + r32] = bfr(o[d0][r] * rli[r]); }
      asm volatile("s_waitcnt lgkmcnt(0)" ::: "memory");
#pragma unroll
      for (int i = 0; i < 4; ++i) { const int row = i * 8 + (lane >> 3), ch = lane & 7; const u32x4 v = *(const u32x4*)(stg + row * 64 + ch * 8); *(u32x4*)(Ow + (long)row * DM + ch * 8) = v; } }
    asm volatile("s_waitcnt lgkmcnt(0)\n\ts_barrier" ::: "memory");
#undef DMA_T
}
__device__ __forceinline__ void fox_phase(const Ctx& C, const bf16* Q, const bf16* K, const bf16* V, const bf16* KX, const float* Gf, bf16* O) {
    for (int u = C.vcu; u < 2048; u += C.G) {
        const int v = u & 255, i = u >> 8, bh = v >> 3, s = v & 7; const int base = (i >> 1) * 16; const int qb = (i & 1) ? base + 15 - s : base + s;
        fox_unit<8>(bh >> 4, bh & 15, qb, Q, K, V, KX, Gf, O, (char*)C.lds);
    }
}
}
namespace fa {
constexpr int L_SEL = L_KX, L_BT = L_KX + 2048, L_IMP = L_OST;
static_assert(L_IMP + 65536 <= 131072, "NSA LDS map");
typedef __attribute__((address_space(3))) float lds_f32;
typedef __attribute__((address_space(3))) unsigned lds_u32;

template <int KIND  >
__device__ __forceinline__ void fix_tile(f32x16& p0, f32x16& p1, int key0, int t, const lds_f32* btl, int hi) {
#pragma unroll
    for (int r = 0; r < 16; ++r) {
#pragma unroll
        for (int hf = 0; hf < 2; ++hf) {
            const int key = key0 + (r & 3) + 8 * (r >> 2) + 4 * hi + 32 * hf;
            const int dist = KIND == 0 ? t - (16 * key + 31) : t - key;
            const bool valid = dist >= 0 && (KIND != 2 || dist < 512);
            int dc = dist < 0 ? 0 : dist; dc = dc > 127 ? 127 : dc;
            const float corr = btl[dc];
            if (hf) p1[r] = valid ? p1[r] + corr : -INFINITY; else p0[r] = valid ? p0[r] + corr : -INFINITY;
        }
    }
}

struct NsaArgs { const bf16* Q; const bf16* KV6; size_t kvs; const bf16* kcmp; const bf16* vcmp; const float* relb; const float* gates; bf16* O; };

template <int THRL>
__device__ __forceinline__ void nsa_unit(int b, int g, int tb, const NsaArgs& A, char* shm) {
    int tid = threadIdx.x; asm volatile("" : "+v"(tid));
    const int lane = tid & 63, r32 = lane & 31, hi = lane >> 5; const int wid = __builtin_amdgcn_readfirstlane(tid >> 6);
    const int t0 = tb * 64, tokl = wid * 8 + (r32 & 7), t = t0 + tokl, hl = r32 >> 3, head = 4 * g + hl;
    const long tokrow = (long)b * SEQ + t;
    const unsigned lds0 = (unsigned)(uintptr_t)shm; float* wsf = (float*)(shm + L_WS) + wid * 64;
    const lds_cptr shm3 = (lds_cptr)shm; const lds_cptr kp0 = shm3 + L_K + hi * 1024 + r32 * 16;
    const int vb0 = (int)(lds0 + L_V) + ((lane >> 4) & 1) * 32 + (lane & 3) * 8 + (4 * hi + ((lane & 15) >> 2)) * 64;
    const unsigned kdst = lds0 + L_K + wid * 1024, vdst = lds0 + L_V + wid * 1024;
    lds_f32* bt = (lds_f32*)(shm3 + L_BT); const lds_f32* btl = bt + hl * 128;
    lds_f32* imp = (lds_f32*)(shm3 + L_IMP); lds_u32* selm = (lds_u32*)(shm3 + L_SEL);
    { const int e = tid; const int hh = e >> 7, d = e & 127; const int hd = 4 * g + hh;
      bt[e] = d < 113 ? (A.relb[(int)T5B[d] * 16 + hd] - A.relb[31 * 16 + hd]) * LOG2E : 0.f; }
    const float b31 = A.relb[31 * 16 + head] * LOG2E;
    bf16x8 qr[4];
    { const bf16* Qw = A.Q + tokrow * DM + head * HD;
#pragma unroll
      for (int d0 = 0; d0 < 4; ++d0) qr[d0] = *reinterpret_cast<const bf16x8*>(&Qw[d0 * 16 + hi * 8]); }
    const float g0 = A.gates[tokrow * 48 + head], g1 = A.gates[tokrow * 48 + 16 + head], g2 = A.gates[tokrow * 48 + 32 + head];
    lds_f32* accl = (lds_f32*)(shm3 + L_IMP) + wid * 2048;
    f32x16 o[2]; float mhat, l_reg;
    const bf16* ksrc; const bf16* vsrc; long tstep;
#define NSA_SRC(Kh, Vh, pitch) do { ksrc = (Kh) + (long)lane * (pitch) + wid * 8; vsrc = (Vh) + (long)(16 * (wid & 3) + (lane >> 2)) * (pitch) + (wid >> 2) * 32 + (lane & 3) * 8; tstep = 64L * (pitch); } while (0)
#define NSA_DMA(tile, sl) do { glds16(ksrc + (long)(tile) * tstep, (unsigned)__builtin_amdgcn_readfirstlane(kdst + (sl) * SLOTB)); \
                               glds16(vsrc + (long)(tile) * tstep, (unsigned)__builtin_amdgcn_readfirstlane(vdst + (sl) * SLOTB)); } while (0)
#define NSA_LOOP(ta, te, ...) do { const int ta_ = (ta), te_ = (te); \
        NSA_DMA(ta_, 0); if (ta_ + 1 < te_) NSA_DMA(ta_ + 1, 1); \
        int sl = 0; \
        for (int tile = ta_; tile < te_; ++tile) { \
            if (tile + 1 < te_) { FA_WAIT_BAR(2); } else { FA_WAIT_BAR(0); } \
            if (tile + 2 < te_) { const int s2 = sl >= 1 ? sl - 1 : 2; NSA_DMA(tile + 2, s2); } \
            __VA_ARGS__ \
            sl = sl == 2 ? 0 : sl + 1; } \
        asm volatile("s_waitcnt lgkmcnt(0)\n\ts_barrier" ::: "memory"); } while (0)
#define NSA_FILL(c0v) do { const float c0_ = (c0v); _Pragma("unroll") for (int r = 0; r < 16; ++r) { p0[r] = c0_; p1[r] = c0_; } } while (0)
#define NSA_ACC(fac, FIRST) do { if (hi == 0) wsf[32 + r32] = (fac); asm volatile("s_waitcnt lgkmcnt(0)" ::: "memory"); \
        _Pragma("unroll") for (int d = 0; d < 2; ++d) _Pragma("unroll") for (int r = 0; r < 16; ++r) { lds_f32* a_ = accl + crow(r, hi) * 64 + d * 32 + r32; \
            const float v_ = o[d][r] * wsf[32 + crow(r, hi)]; *a_ = (FIRST) ? v_ : *a_ + v_; } \
        asm volatile("s_waitcnt lgkmcnt(0)" ::: "memory"); } while (0)

    const int nvmax = (4 * tb + 3) > NCMP ? NCMP : (4 * tb + 3);
    const int NTc = (nvmax + 63) >> 6;
    const int cnear = (4 * tb - 9) < 0 ? 0 : ((4 * tb - 9) >> 6);
    const bf16* Kc = A.kcmp + (size_t)((b * NGRP + g) * NCMPP) * 64; const bf16* Vc = A.vcmp + (size_t)((b * NGRP + g) * NCMPP) * 64;
    NSA_SRC(Kc, Vc, 64);
    mhat = 0.f; l_reg = 0.f;
    NSA_LOOP(0, NTc, {
        f32x16 p0, p1; NSA_FILL(b31 - mhat);
        qkt_acc(p0, p1, kp0 + sl * SLOTB, qr);
        if (tile >= cnear) fix_tile<0>(p0, p1, 64 * tile, t, btl, hi);
        const float rm = rowmax(p0, p1);
        if (__any(rm > 0.f)) { const float dl = __builtin_fmaxf(rm, 0.f); mhat += dl;
            _Pragma("unroll") for (int r = 0; r < 16; ++r) { p0[r] -= dl; p1[r] -= dl; }
            l_reg *= __builtin_amdgcn_exp2f(-dl); }
        float s0 = 0.f, s1 = 0.f;
        _Pragma("unroll") for (int r = 0; r < 16; ++r) { s0 += __builtin_amdgcn_exp2f(p0[r]); s1 += __builtin_amdgcn_exp2f(p1[r]); }
        l_reg += s0 + s1;
    });
    { auto rr = __builtin_amdgcn_permlane32_swap(__float_as_uint(l_reg), __float_as_uint(l_reg), false, false); l_reg = __uint_as_float(rr[0]) + __uint_as_float(rr[1]); }
    const float ref2 = l_reg > 0.f ? mhat + __builtin_amdgcn_logf(l_reg) : 0.f;
    o[0] = f32x16{}; o[1] = f32x16{};
    float carry = 0.f;
    NSA_LOOP(0, NTc, {
        f32x16 p0, p1; NSA_FILL(b31 - ref2);
        qkt_acc(p0, p1, kp0 + sl * SLOTB, qr);
        if (tile >= cnear) fix_tile<0>(p0, p1, 64 * tile, t, btl, hi);
        _Pragma("unroll") for (int r = 0; r < 16; ++r) { p0[r] = __builtin_amdgcn_exp2f(p0[r]); p1[r] = __builtin_amdgcn_exp2f(p1[r]); }
        { float e_lo[2][4], e_hi[2][4], sg[2][4];
          _Pragma("unroll") for (int hf = 0; hf < 2; ++hf) _Pragma("unroll") for (int q = 0; q < 4; ++q) {
              const f32x16& pp = hf ? p1 : p0; const float x = pp[4 * q + 3];
              auto rr = __builtin_amdgcn_permlane32_swap(__float_as_uint(x), __float_as_uint(x), false, false);
              e_hi[hf][q] = __uint_as_float(rr[0]);
              e_lo[hf][q] = __uint_as_float(rr[1]);
              sg[hf][q] = (pp[4 * q] + pp[4 * q + 1]) + (pp[4 * q + 2] + pp[4 * q + 3]); }
          _Pragma("unroll") for (int hf = 0; hf < 2; ++hf) _Pragma("unroll") for (int q = 0; q < 4; ++q) {
              const float prev_lo = (q > 0) ? e_lo[hf][q - 1] : (hf ? e_lo[0][3] : carry);
              float v = sg[hf][q] + (hi ? e_hi[hf][q] : prev_lo);
              v += __shfl_xor(v, 8); v += __shfl_xor(v, 16);
              if (r32 < 8) imp[(wid * 8 + r32) * 256 + 16 * tile + 8 * hf + 2 * q + hi] = v; }
          carry = e_lo[1][3]; }
        { u32x4 pw0 = {cvtpk(p0[0], p0[1]), cvtpk(p0[2], p0[3]), cvtpk(p0[4], p0[5]), cvtpk(p0[6], p0[7])};
          u32x4 pw1 = {cvtpk(p0[8], p0[9]), cvtpk(p0[10], p0[11]), cvtpk(p0[12], p0[13]), cvtpk(p0[14], p0[15])};
          u32x4 pw2 = {cvtpk(p1[0], p1[1]), cvtpk(p1[2], p1[3]), cvtpk(p1[4], p1[5]), cvtpk(p1[6], p1[7])};
          u32x4 pw3 = {cvtpk(p1[8], p1[9]), cvtpk(p1[10], p1[11]), cvtpk(p1[12], p1[13]), cvtpk(p1[14], p1[15])};
          FA_SBAR();
          pv(o, vb0 + sl * SLOTB, __builtin_bit_cast(bf16x8, pw0), __builtin_bit_cast(bf16x8, pw1), __builtin_bit_cast(bf16x8, pw2), __builtin_bit_cast(bf16x8, pw3)); }
    });
    for (int tk = 0; tk < 8; ++tk) {
        const lds_f32* row = imp + (wid * 8 + tk) * 256;
        float val[4];
#pragma unroll
        for (int k = 0; k < 4; ++k) { const int j = lane + 64 * k; const float v = (j < 16 * NTc) ? row[j] : 0.f;
            const bool forced = (j == 0) || (j == tb) || (j == tb - 1);
            val[k] = forced ? 1e9f : (j <= tb ? v : -1e30f); }
        unsigned mw = 0u;
        for (int r = 0; r < 16; ++r) {
            float bv = val[0]; int bj = lane;
#pragma unroll
            for (int k = 1; k < 4; ++k) if (val[k] > bv) { bv = val[k]; bj = lane + 64 * k; }
#pragma unroll
            for (int of = 1; of < 64; of <<= 1) { const float ov = __shfl_xor(bv, of); const int oj = __shfl_xor(bj, of); if (ov > bv || (ov == bv && oj < bj)) { bv = ov; bj = oj; } }
            if (bv > -0.5e30f && lane == (bj >> 5)) mw |= 1u << (bj & 31);
            if ((bj & 63) == lane) {
#pragma unroll
                for (int k = 0; k < 4; ++k) if (k == (bj >> 6)) val[k] = -3e38f; }
        }
        if (lane < 8) selm[(wid * 8 + tk) * 8 + lane] = mw;
    }
    asm volatile("s_waitcnt lgkmcnt(0)" ::: "memory");
    NSA_ACC(g0, true);
    NSA_SRC(A.KV6 + 2 * A.kvs + (size_t)b * SEQ * 256 + g * 64, A.KV6 + 3 * A.kvs + (size_t)b * SEQ * 256 + g * 64, 256);
    mhat = 0.f; l_reg = 0.f; o[0] = f32x16{}; o[1] = f32x16{};
    NSA_LOOP(0, tb + 1, {
        const unsigned mwv = selm[tokl * 8 + (tile >> 5)]; const bool selb = (mwv >> (tile & 31)) & 1u;
        if (__any(selb)) {
            f32x16 p0, p1; NSA_FILL(selb ? b31 - mhat : -INFINITY);
            qkt_acc(p0, p1, kp0 + sl * SLOTB, qr);
            if (tile + 2 >= tb) fix_tile<1>(p0, p1, 64 * tile, t, btl, hi);
            bool moved; softmax_pv<THRL>(p0, p1, o, mhat, l_reg, moved, wsf, vb0 + sl * SLOTB, r32, hi);
        }
    });
    { auto rr = __builtin_amdgcn_permlane32_swap(__float_as_uint(l_reg), __float_as_uint(l_reg), false, false); l_reg = __uint_as_float(rr[0]) + __uint_as_float(rr[1]); }
    NSA_ACC(l_reg > 0.f ? g1 / l_reg : 0.f, false);
    NSA_SRC(A.KV6 + 4 * A.kvs + (size_t)b * SEQ * 256 + g * 64, A.KV6 + 5 * A.kvs + (size_t)b * SEQ * 256 + g * 64, 256);
    mhat = 0.f; l_reg = 0.f; o[0] = f32x16{}; o[1] = f32x16{};
    NSA_LOOP((tb >= 8 ? tb - 8 : 0), tb + 1, {
        f32x16 p0, p1; NSA_FILL(b31 - mhat);
        qkt_acc(p0, p1, kp0 + sl * SLOTB, qr);
        if (tile + 2 >= tb || tile + 8 == tb) fix_tile<2>(p0, p1, 64 * tile, t, btl, hi);
        bool moved; softmax_pv<THRL>(p0, p1, o, mhat, l_reg, moved, wsf, vb0 + sl * SLOTB, r32, hi);
    });
    { auto rr = __builtin_amdgcn_permlane32_swap(__float_as_uint(l_reg), __float_as_uint(l_reg), false, false); l_reg = __uint_as_float(rr[0]) + __uint_as_float(rr[1]); }
    NSA_ACC(l_reg > 0.f ? g2 / l_reg : 0.f, false);
#pragma unroll
    for (int i = 0; i < 4; ++i) { const int row = i * 8 + (lane >> 3), ch = lane & 7;
        const f32x4 v0 = *(const __attribute__((address_space(3))) f32x4*)(accl + row * 64 + ch * 8), v1 = *(const __attribute__((address_space(3))) f32x4*)(accl + row * 64 + ch * 8 + 4);
        u32x4 w; w.x = cvtpk(v0[0], v0[1]); w.y = cvtpk(v0[2], v0[3]); w.z = cvtpk(v1[0], v1[1]); w.w = cvtpk(v1[2], v1[3]);
        bf16* dst = A.O + ((long)b * SEQ + t0 + wid * 8 + (row & 7)) * DM + (4 * g + (row >> 3)) * HD + ch * 8; *(u32x4*)dst = w; }
    asm volatile("s_waitcnt lgkmcnt(0)\n\ts_barrier" ::: "memory");
#undef NSA_SRC
#undef NSA_DMA
#undef NSA_LOOP
#undef NSA_FILL
#undef NSA_ACC
}
__device__ __forceinline__ void nsa_phase(const Ctx& C, const NsaArgs& A) {
    for (int u = C.vcu; u < 2048; u += C.G) {
        const int v = u & 255, i = u >> 8, bg = v >> 5, s = v & 31; const int base = (i >> 1) * 64; const int tb = (i & 1) ? base + 63 - s : base + s;
        nsa_unit<8>(bg >> 2, bg & 3, tb, A, (char*)C.lds);
    }
}
}
__device__ __forceinline__ bool refresh(Ctx& C) { int t = threadIdx.x; asm volatile("" : "+v"(t)); C.tid = t; C.lane = t & 63; C.wave = __builtin_amdgcn_readfirstlane(t >> 6); return true; }
struct Args { const float* in[18]; float* out; unsigned char* ws; int ph_lo, ph_hi; };
__global__ void __launch_bounds__(NTHREADS, 2) fwd_kernel(Args args) {
    extern __shared__ __attribute__((aligned(16))) unsigned char lds[];
    Ctx C; C.tid = threadIdx.x; C.lane = C.tid & 63; C.wave = __builtin_amdgcn_readfirstlane(C.tid >> 6); C.G = gridDim.x; C.lds = lds;
    { const int bx = blockIdx.x; C.vcu = (C.G % 8 == 0) ? (bx % 8) * (C.G / 8) + bx / 8 : bx; }
    unsigned char* ws = args.ws; const float* const* in = args.in;
    gu32* ctl = (gu32*)(ws + WS_CTL);
    LAS unsigned char* ldsl = (LAS unsigned char*)lds;
    volatile LAS unsigned* MISC = (volatile LAS unsigned*)(ldsl + MISC_OFF);
    for (int u = C.tid; u < (LDS_BYTES - LDSCTL_OFF) / 4; u += NTHREADS) ((LAS unsigned*)(ldsl + LDSCTL_OFF))[u] = 0u;
    __syncthreads();
    const int lo = args.ph_lo, hi = args.ph_hi;
    XcdBarrier bar; bar.bar = (unsigned*)(ctl + CW_BAR); bar.x = 0; bar.st = nullptr;
    if (hi - lo > 1) bar = xcd_barrier_post((unsigned*)(ctl + CW_BAR), MISC + 8);
#define IN(k) (lo <= (k) && (k) < hi && refresh(C))
#define SEAM(k) do { if (lo <= (k) && (k) + 1 < hi) xcd_barrier(bar); } while (0)
    bf16* Wfoxin = (bf16*)(ws + WS_WFOXIN); bf16* Wfoxout = (bf16*)(ws + WS_WFOXOUT); bf16* Wnsain = (bf16*)(ws + WS_WNSAIN); bf16* Wnsaout = (bf16*)(ws + WS_WNSAOUT);
    float* mod = (float*)(ws + WS_MOD); float* cb1 = (float*)(ws + WS_CB1); float* flogit = (float*)(ws + WS_FLOGIT); float* Gf = (float*)(ws + WS_G); float* gates = (float*)(ws + WS_GATES);
    bf16* kcmp = (bf16*)(ws + WS_KCMP); bf16* vcmp = (bf16*)(ws + WS_VCMP); unsigned* SEL = (unsigned*)(ws + WS_SEL);
    bf16* HB = (bf16*)(ws + WS_HBUF); bf16* QO = (bf16*)(ws + WS_R); bf16* KB = (bf16*)(ws + WS_R + 64 * MiB); bf16* VB = (bf16*)(ws + WS_R + 128 * MiB);
    bf16* KV6 = (bf16*)(ws + WS_R + 64 * MiB); const size_t KVS = (size_t)(16 * MiB) / 2;
    bf16* UB = (bf16*)(ws + WS_R); float* OC = (float*)(ws + WS_OC); bf16* KXB = (bf16*)(ws + WS_KX);
    float* XZ = args.out;
    const float* x_in = in[0];

    if (IN(0)) { p_prep(C, in, ws); } SEAM(0);
    if (IN(1)) { p_modrows(C, x_in, mod, 0, DM, HB); } SEAM(1);
    if (IN(2)) { pg8::Gemm g{HB, Wfoxin, TOK, FOXNP, DM}; pg8::StaticOrder S; S.init(TOK, FOXNP, C.G, (int)blockIdx.x);
        pg8::EpiFoxIn E{QO, (size_t)(64 * MiB) / 2, flogit};
        pg8::gemm_phase<pg8::EpiFoxIn, pg8::StaticOrder, true, true>(ldsl, g, S, E); } SEAM(2);
    if (IN(3)) { p_scan(C, flogit, in[7], Gf, KXB); } SEAM(3);
    if (IN(4)) { fa::fox_phase(C, QO, KB, VB, KXB, Gf, QO); } SEAM(4);
    if (IN(5)) { pg8::Gemm g{QO, Wfoxout, TOK, DM, DM}; pg8::StaticOrder S; S.init(TOK, DM, C.G, (int)blockIdx.x);
        pg8::EpiResid E{x_in, XZ, mod + 2 * DM, 6 * DM, SEQ, DN_ALPHA};
        pg8::gemm_phase<pg8::EpiResid, pg8::StaticOrder, true, true>(ldsl, g, S, E); } SEAM(5);
    if (IN(6)) { p_lnrows(C, XZ, in[4] + 0 * DM, in[5] + 0 * DM, mod, 3 * DM, 4 * DM, HB); } SEAM(6);
    if (IN(7)) { pg8::Gemm g{HB, (bf16*)(ws + WS_WFFIN0), TOK, 2 * FF, DM}; pg8::StaticOrder S; S.init(TOK, 2 * FF, C.G, (int)blockIdx.x);
        pg8::EpiSwiGLU E{UB, FF};
        pg8::gemm_phase<pg8::EpiSwiGLU, pg8::StaticOrder, true, true>(ldsl, g, S, E); } SEAM(7);
    if (IN(8)) { pg8::Gemm g{UB, (bf16*)(ws + WS_WFFOUT0), TOK, DM, FF}; pg8::StaticOrder S; S.init(TOK, DM, C.G, (int)blockIdx.x);
        pg8::EpiResid E{XZ, XZ, mod + 5 * DM, 6 * DM, SEQ, DN_ALPHA};
        pg8::gemm_phase<pg8::EpiResid, pg8::StaticOrder, true, true>(ldsl, g, S, E); } SEAM(8);
    const float* mod1 = mod + BATCH * 6 * DM;
    if (IN(9)) { p_lnrows(C, XZ, in[4] + 1 * DM, in[5] + 1 * DM, mod1, 0, DM, HB); } SEAM(9);
    if (IN(10)) { pg8::Gemm g{HB, Wnsain, TOK, NSANP, DM}; pg8::StaticOrder S; S.init(TOK, NSANP, C.G, (int)blockIdx.x);
        pg8::EpiNsaIn E{QO, KV6, KVS, gates, in[10]};
        pg8::gemm_phase<pg8::EpiNsaIn, pg8::StaticOrder, true, true>(ldsl, g, S, E); } SEAM(10);
    if (IN(11)) { p_compress_naive(C, KV6, KVS, in[12], in[13], cb1, kcmp, vcmp); } SEAM(11);
    if (IN(12)) { fa::NsaArgs NA{QO, KV6, KVS, kcmp, vcmp, in[15], gates, QO}; fa::nsa_phase(C, NA); } SEAM(12);
    if (IN(13)) { } SEAM(13);
    if (IN(14)) { pg8::Gemm g{QO, Wnsaout, TOK, DM, DM}; pg8::StaticOrder S; S.init(TOK, DM, C.G, (int)blockIdx.x);
        pg8::EpiResid E{XZ, XZ, mod1 + 2 * DM, 6 * DM, SEQ, DN_ALPHA};
        pg8::gemm_phase<pg8::EpiResid, pg8::StaticOrder, true, true>(ldsl, g, S, E); } SEAM(14);
    if (IN(15)) { p_lnrows(C, XZ, in[4] + 2 * DM, in[5] + 2 * DM, mod1, 3 * DM, 4 * DM, HB); } SEAM(15);
    if (IN(16)) { pg8::Gemm g{HB, (bf16*)(ws + WS_WFFIN1), TOK, 2 * FF, DM}; pg8::StaticOrder S; S.init(TOK, 2 * FF, C.G, (int)blockIdx.x);
        pg8::EpiSwiGLU E{UB, FF};
        pg8::gemm_phase<pg8::EpiSwiGLU, pg8::StaticOrder, true, true>(ldsl, g, S, E); } SEAM(16);
    if (IN(17)) { pg8::Gemm g{UB, (bf16*)(ws + WS_WFFOUT1), TOK, DM, FF}; pg8::StaticOrder S; S.init(TOK, DM, C.G, (int)blockIdx.x);
        pg8::EpiResid E{XZ, XZ, mod1 + 5 * DM, 6 * DM, SEQ, DN_ALPHA};
        pg8::gemm_phase<pg8::EpiResid, pg8::StaticOrder, true, true>(ldsl, g, S, E); } SEAM(17);
    if (IN(18)) { p_lnrows(C, XZ, in[4] + 3 * DM, in[5] + 3 * DM, mod1, 0, 0, nullptr); }
#undef IN
#undef SEAM
}

extern "C" void kernel_launch(void* const* d_in, const int* in_sizes, int n_in, void* d_out, int out_size, void* d_ws, size_t ws_size, hipStream_t stream) {
    static int grid = 0;
    if (grid == 0) {
        if (n_in != 18 || in_sizes[0] != TOK * DM || out_size != TOK * DM || ws_size < WS_END) { fprintf(stderr, "kernel_launch: unexpected shapes (n_in %d, in0 %d, out %d, ws %zu)\n", n_in, n_in > 0 ? in_sizes[0] : -1, out_size, ws_size); grid = -1; return; }
        int dev = 0, cus = 0, per_cu = 0;
        if (hipGetDevice(&dev) != hipSuccess || hipDeviceGetAttribute(&cus, hipDeviceAttributeMultiprocessorCount, dev) != hipSuccess) { grid = -1; return; }
        if (hipFuncSetAttribute((const void*)fwd_kernel, hipFuncAttributeMaxDynamicSharedMemorySize, LDS_BYTES) != hipSuccess) { fprintf(stderr, "kernel_launch: hipFuncSetAttribute failed\n"); grid = -1; return; }
        if (hipOccupancyMaxActiveBlocksPerMultiprocessor(&per_cu, (const void*)fwd_kernel, NTHREADS, LDS_BYTES) != hipSuccess || per_cu < 1) fprintf(stderr, "kernel_launch: occupancy query reports %d\n", per_cu);
        (void)hipGetLastError();
        grid = cus;
        if (grid != 256) fprintf(stderr, "kernel_launch: note: %d CUs\n", grid);
    }
    if (grid < 0) return;
    (void)hipMemsetAsync((char*)d_ws + WS_CTL, 0, CTL_ZERO_BYTES, stream);
    Args a{};
    for (int i = 0; i < 18; ++i) a.in[i] = (const float*)d_in[i];
    a.out = (float*)d_out; a.ws = (unsigned char*)d_ws;
#if MK_PER_PHASE
    for (int p = 0; p < N_PHASES; ++p) { a.ph_lo = p; a.ph_hi = p + 1; hipLaunchKernelGGL(fwd_kernel, dim3(grid), dim3(NTHREADS), LDS_BYTES, stream, a); }
#else
    a.ph_lo = 0; a.ph_hi = N_PHASES;
    hipLaunchKernelGGL(fwd_kernel, dim3(grid), dim3(NTHREADS), LDS_BYTES, stream, a);
#endif
}
```

```cpp
#include <hip/hip_runtime.h>
#include <hip/hip_bf16.h>
#include <cstdio>
#include <cstdint>
#include <cmath>
namespace pg8 {
#define PG8_LAS __attribute__((address_space(3)))
typedef unsigned short bf16_t;
typedef short bf16x8 __attribute__((ext_vector_type(8)));
typedef float f32x4 __attribute__((ext_vector_type(4)));
typedef unsigned u32x4 __attribute__((ext_vector_type(4)));
constexpr int BM = 256, BK = 64, HALF = 128, HTB = HALF * BK * 2  , STAGE_BYTES = 8 * HTB, NXCD = 8, WGM = 8;

__host__ __device__ __forceinline__ int lds_byte(int r, int c) { const int st = (r >> 4) * 2 + (c >> 5), rr = r & 15, cc = c & 31, ob = rr * 64 + cc * 2; return st * 1024 + (ob ^ (((ob >> 9) & 1) << 5)); }
__host__ __device__ __forceinline__ void stage_rc(int b, int& R, int& C) { const int st = b / 1024, sb = b % 1024, swz = sb ^ (((sb >> 9) & 1) << 5); R = (st >> 1) * 16 + swz / 64; C = (st & 1) * 32 + (swz % 64) / 2; }
__host__ __device__ __forceinline__ int perm32(int rho) { const int n = rho >> 4, i = rho & 15; return 8 * (i >> 2) + 4 * n + (i & 3); }

struct Unit { int pm, pn; };
struct Gemm { const bf16_t* A; const bf16_t* Bt; int M, N, K; };

struct StaticOrder {
    int nM, nN, nwg, G, c;
    __host__ __device__ void init(int M, int N, int G_, int c_) { nM = M / BM; nN = N / BM; nwg = nM * nN; G = G_; c = c_; }
    __host__ __device__ bool next(int i, Unit& u) const {
        const long L = (long)i * G + c; if (L >= nwg) return false;
        int wgid = (int)L; { const int q = nwg / NXCD, r = nwg % NXCD, xcd = wgid % NXCD, off = wgid / NXCD; wgid = (xcd < r ? xcd * (q + 1) : r * (q + 1) + (xcd - r) * q) + off; }
        const int nig = WGM * nN, gid = wgid / nig, fm = gid * WGM, gsz = (nM - fm) < WGM ? (nM - fm) : WGM;
        u.pm = fm + ((wgid % nig) % gsz); u.pn = (wgid % nig) / gsz; return true;
    }
    __device__ __forceinline__ void a_ready(const Unit&) const {}
    __device__ __forceinline__ void done(const Unit&) const {}
};

__device__ __forceinline__ unsigned cvt_pk_bf16(float lo, float hi) { unsigned r; asm volatile("v_cvt_pk_bf16_f32 %0, %1, %2" : "=v"(r) : "v"(lo), "v"(hi)); return r; }
typedef float f32x2 __attribute__((ext_vector_type(2)));
typedef float f32x2 __attribute__((ext_vector_type(2)));
constexpr float QSCALE = 0.125f * 1.4426950408889634f;
__device__ __forceinline__ u32x4 pack8(f32x4 v0, f32x4 v1) { u32x4 w; w.x = cvt_pk_bf16(v0[0], v0[1]); w.y = cvt_pk_bf16(v0[2], v0[3]); w.z = cvt_pk_bf16(v1[0], v1[1]); w.w = cvt_pk_bf16(v1[2], v1[3]); return w; }
struct EpiFoxIn {
    static constexpr bool PERM = true, AFTER_DRAIN = false;
    bf16_t* Q; size_t qkv_stride; float* flogit;
    __device__ __forceinline__ void operator()(const f32x4 (&acc)[2][2][4][2], const Unit& u, int wr, int wc, int fr, int fq) const {
        const int row0 = u.pm * BM + wr * 64 + fr;
        if (u.pn < 12) {
            const int t = u.pn >> 2; bf16_t* base = Q + (size_t)t * qkv_stride; const float sc = t == 0 ? QSCALE : 1.f;
            const int col0 = (u.pn & 3) * BM + wc * 32 + 8 * fq;
#pragma unroll
            for (int ai = 0; ai < 2; ++ai)
#pragma unroll
                for (int m = 0; m < 4; ++m) { bf16_t* rowp = base + (size_t)(row0 + ai * HALF + m * 16) * 1024 + col0;
#pragma unroll
                    for (int bj = 0; bj < 2; ++bj) *(u32x4*)(rowp + bj * HALF) = pack8(acc[ai][bj][m][0] * sc, acc[ai][bj][m][1] * sc); }
        } else if (wc == 0 && fq < 2) {
#pragma unroll
            for (int ai = 0; ai < 2; ++ai)
#pragma unroll
                for (int m = 0; m < 4; ++m) { float* rowp = flogit + (size_t)(row0 + ai * HALF + m * 16) * 16 + 8 * fq;
                    *(f32x4*)(rowp) = acc[ai][0][m][0]; *(f32x4*)(rowp + 4) = acc[ai][0][m][1]; }
        }
    }
};
struct EpiNsaIn {
    static constexpr bool PERM = true, AFTER_DRAIN = false;
    bf16_t* Q; bf16_t* KV; size_t kv_stride; float* gates; const float* bgate;
    __device__ __forceinline__ void operator()(const f32x4 (&acc)[2][2][4][2], const Unit& u, int wr, int wc, int fr, int fq) const {
        const int row0 = u.pm * BM + wr * 64 + fr;
        if (u.pn < 4) {
            const int col0 = u.pn * BM + wc * 32 + 8 * fq;
#pragma unroll
            for (int ai = 0; ai < 2; ++ai)
#pragma unroll
                for (int m = 0; m < 4; ++m) { bf16_t* rowp = Q + (size_t)(row0 + ai * HALF + m * 16) * 1024 + col0;
#pragma unroll
                    for (int bj = 0; bj < 2; ++bj) *(u32x4*)(rowp + bj * HALF) = pack8(acc[ai][bj][m][0] * QSCALE, acc[ai][bj][m][1] * QSCALE); }
        } else if (u.pn < 10) {
            bf16_t* base = KV + (size_t)(u.pn - 4) * kv_stride; const int col0 = wc * 32 + 8 * fq;
#pragma unroll
            for (int ai = 0; ai < 2; ++ai)
#pragma unroll
                for (int m = 0; m < 4; ++m) { bf16_t* rowp = base + (size_t)(row0 + ai * HALF + m * 16) * 256 + col0;
#pragma unroll
                    for (int bj = 0; bj < 2; ++bj) *(u32x4*)(rowp + bj * HALF) = pack8(acc[ai][bj][m][0], acc[ai][bj][m][1]); }
        } else if (wc == 0 || (wc == 1 && fq < 2)) {
            const int lc = wc * 32 + 8 * fq;
            f32x4 b0 = *(const f32x4*)(bgate + lc), b1 = *(const f32x4*)(bgate + lc + 4);
#pragma unroll
            for (int ai = 0; ai < 2; ++ai)
#pragma unroll
                for (int m = 0; m < 4; ++m) { float* rowp = gates + (size_t)(row0 + ai * HALF + m * 16) * 48 + lc;
                    f32x4 v0 = acc[ai][0][m][0] + b0, v1 = acc[ai][0][m][1] + b1;
#pragma unroll
                    for (int i = 0; i < 4; ++i) { v0[i] = 1.f / (1.f + __expf(-v0[i])); v1[i] = 1.f / (1.f + __expf(-v1[i])); }
                    *(f32x4*)(rowp) = v0; *(f32x4*)(rowp + 4) = v1; }
        }
    }
};
struct EpiSwiGLU {
    static constexpr bool PERM = true, AFTER_DRAIN = false;
    bf16_t* U; int ldu;
    __device__ __forceinline__ void operator()(const f32x4 (&acc)[2][2][4][2], const Unit& u, int wr, int wc, int fr, int fq) const {
        const int row0 = u.pm * BM + wr * 64 + fr; const int col0 = u.pn * HALF + wc * 32 + 8 * fq;
#pragma unroll
        for (int ai = 0; ai < 2; ++ai)
#pragma unroll
            for (int m = 0; m < 4; ++m) { f32x4 r[2];
#pragma unroll
                for (int n = 0; n < 2; ++n) { const f32x4 a = acc[ai][0][m][n], b = acc[ai][1][m][n];
#pragma unroll
                    for (int i = 0; i < 4; ++i) r[n][i] = a[i] * b[i] / (1.f + __expf(-a[i])); }
                *(u32x4*)(U + (size_t)(row0 + ai * HALF + m * 16) * ldu + col0) = pack8(r[0], r[1]); }
    }
};
struct EpiResid {
    static constexpr bool PERM = false, AFTER_DRAIN = false;
    const float* xres; float* z; const float* gate; int gate_bstride; int rows_per_batch; float alpha;
    __device__ __forceinline__ void operator()(const f32x4 (&acc)[2][2][4][2], const Unit& u, int wr, int wc, int fr, int fq) const {
        const int b = (u.pm * BM) / rows_per_batch; const float* g = gate + (size_t)b * gate_bstride;
        const int col0 = u.pn * BM + wc * 32 + 4 * fq;
        f32x4 gv[2][2];
#pragma unroll
        for (int bj = 0; bj < 2; ++bj)
#pragma unroll
            for (int n = 0; n < 2; ++n) gv[bj][n] = *(const f32x4*)(g + col0 + bj * HALF + n * 16) + 1.0f;
#pragma unroll
        for (int ai = 0; ai < 2; ++ai)
#pragma unroll
            for (int m = 0; m < 4; ++m) { const size_t off = (size_t)(u.pm * BM + ai * HALF + wr * 64 + m * 16 + fr) * 1024 + col0;
#pragma unroll
                for (int bj = 0; bj < 2; ++bj)
#pragma unroll
                    for (int n = 0; n < 2; ++n) { const f32x4 xv = *(const f32x4*)(xres + off + bj * HALF + n * 16);
                        *(f32x4*)(z + off + bj * HALF + n * 16) = xv * alpha + gv[bj][n] * acc[ai][bj][m][n]; } }
    }
};
template <class Epi, class Sched, bool ALIGN_EPI = false, bool SP2 = false>
__device__ __forceinline__ void gemm_phase(PG8_LAS unsigned char* lds, const Gemm g, const Sched& S, const Epi& E) {
    const int tid = threadIdx.x, wid = __builtin_amdgcn_readfirstlane(tid >> 6), lane = tid & 63, wr = wid >> 2, wc = wid & 3, fr = lane & 15, fq = lane >> 4;
    const int K = g.K, nt = K / BK;
    unsigned voffA[2], voffB[2];
#pragma unroll
    for (int i = 0; i < 2; ++i) { int R, C; stage_rc(tid * 16 + i * 8192, R, C); const int Rb = Epi::PERM ? ((R & ~31) + perm32(R & 31)) : R;
        voffA[i] = (unsigned)(R * K + C) * 2u; voffB[i] = (unsigned)(Rb * K + C) * 2u; }
    const size_t kstep = (size_t)(BK * 2);
    const size_t hstep = (size_t)HALF * K * 2;
    const size_t tstep = 2 * hstep;
    const unsigned ldsw = (unsigned)wid * 1024u;
    const int aoff = lds_byte(wr * 64 + fr, fq * 8), boff = lds_byte(wc * 32 + fr, fq * 8);
#define PG8_SA(b, h) (((b) * 2 + (h)) * HTB)
#define PG8_SB(b, h) ((4 + (b) * 2 + (h)) * HTB)
#define PG8_STAGE(bufoff, gbase, voff) do { _Pragma("unroll") for (int _i = 0; _i < 2; ++_i) \
        __builtin_amdgcn_global_load_lds((const unsigned*)((const char*)(gbase) + (voff)[_i]), (PG8_LAS unsigned*)(lds + (bufoff) + ldsw + _i * 8192), 16, 0, 0); } while (0)
#define PG8_LDA(dst, b, h) do { _Pragma("unroll") for (int m = 0; m < 4; ++m) _Pragma("unroll") for (int k = 0; k < 2; ++k) dst[m][k] = *(const PG8_LAS bf16x8*)(lds + PG8_SA(b, h) + aoff + m * 2048 + k * 1024); } while (0)
#define PG8_LDB(dst, b, h) do { _Pragma("unroll") for (int n = 0; n < 2; ++n) _Pragma("unroll") for (int k = 0; k < 2; ++k) dst[n][k] = *(const PG8_LAS bf16x8*)(lds + PG8_SB(b, h) + boff + n * 2048 + k * 1024); } while (0)
#define PG8_MMA(ai, bj, At, Bt) do { __builtin_amdgcn_s_setprio(1); _Pragma("unroll") for (int m = 0; m < 4; ++m) _Pragma("unroll") for (int n = 0; n < 2; ++n) _Pragma("unroll") for (int k = 0; k < 2; ++k) \
        acc[ai][bj][m][n] = __builtin_amdgcn_mfma_f32_16x16x32_bf16(Bt[n][k], At[m][k], acc[ai][bj][m][n], 0, 0, 0); __builtin_amdgcn_s_setprio(0); } while (0)
#define PG8_WAIT_V(n) asm volatile("s_waitcnt vmcnt(" #n ")" ::: "memory")
#define PG8_WAIT_L(n) asm volatile("s_waitcnt lgkmcnt(" #n ")" ::: "memory")
#define PG8_BAR __builtin_amdgcn_s_barrier()
#define PG8_SCHED __builtin_amdgcn_sched_barrier(0)
    Unit cur, nxt; int ui = 0;
    if (!S.next(0, cur)) return;
    f32x4 acc[2][2][4][2];
#pragma unroll
    for (int a = 0; a < 2; ++a)
#pragma unroll
        for (int b = 0; b < 2; ++b)
#pragma unroll
            for (int m = 0; m < 4; ++m)
#pragma unroll
                for (int n = 0; n < 2; ++n) acc[a][b][m][n] = (f32x4){0.f, 0.f, 0.f, 0.f};
    bf16x8 At[4][2], B0[2][2], B1[2][2];
    const char* cA = (const char*)g.A + (size_t)cur.pm * tstep; const char* cB = (const char*)g.Bt + (size_t)cur.pn * tstep;
    S.a_ready(cur);
    if constexpr (SP2) {
        PG8_STAGE(PG8_SB(0, 0), cB, voffB); PG8_STAGE(PG8_SB(0, 1), cB + hstep, voffB); PG8_STAGE(PG8_SA(0, 0), cA, voffA); PG8_STAGE(PG8_SA(0, 1), cA + hstep, voffA);
        if (wr == 1) PG8_BAR;
        PG8_WAIT_V(2); PG8_BAR;
        PG8_STAGE(PG8_SB(1, 0), cB + kstep, voffB); PG8_STAGE(PG8_SA(1, 0), cA + kstep, voffA); PG8_STAGE(PG8_SB(1, 1), cB + hstep + kstep, voffB);
        PG8_WAIT_V(6); PG8_BAR;
    } else {
        PG8_STAGE(PG8_SB(0, 0), cB, voffB); PG8_STAGE(PG8_SA(0, 0), cA, voffA); PG8_STAGE(PG8_SB(0, 1), cB + hstep, voffB); PG8_STAGE(PG8_SA(0, 1), cA + hstep, voffA);
        if (wr == 1) PG8_BAR;
        PG8_WAIT_V(4); PG8_BAR;
        PG8_STAGE(PG8_SB(1, 0), cB + kstep, voffB); PG8_STAGE(PG8_SA(1, 0), cA + kstep, voffA); PG8_STAGE(PG8_SB(1, 1), cB + hstep + kstep, voffB);
        PG8_WAIT_V(6); PG8_BAR;
    }
    for (;;) {
        const bool has_next = S.next(ui + 1, nxt);
        const char* nA = has_next ? (const char*)g.A + (size_t)nxt.pm * tstep : cA; const char* nB = has_next ? (const char*)g.Bt + (size_t)nxt.pn * tstep : cB;
        for (int t = 0; t < nt; t += 2) {
            const bool last = (t == nt - 2);
            const char* a1 = cA + (size_t)(t + 1) * kstep;
            const char* a2 = last ? nA : cA + (size_t)(t + 2) * kstep; const char* b2 = last ? nB : cB + (size_t)(t + 2) * kstep;
            const char* a3 = a2 + kstep; const char* b3 = b2 + kstep;
            if (last && has_next) S.a_ready(nxt);
            if constexpr (SP2) {
            PG8_LDB(B0, 0, 0); PG8_LDB(B1, 0, 1); PG8_SCHED; PG8_LDA(At, 0, 0); PG8_STAGE(PG8_SA(1, 1), a1 + hstep, voffA);
            PG8_WAIT_V(8); PG8_WAIT_L(0); PG8_BAR; PG8_MMA(0, 0, At, B0); PG8_MMA(0, 1, At, B1); PG8_BAR; PG8_SCHED;
            PG8_LDA(At, 0, 1); PG8_STAGE(PG8_SB(0, 0), b2, voffB); PG8_STAGE(PG8_SB(0, 1), b2 + hstep, voffB); PG8_STAGE(PG8_SA(0, 0), a2, voffA);
            PG8_WAIT_V(8); PG8_WAIT_L(0); PG8_BAR; PG8_MMA(1, 0, At, B0); PG8_MMA(1, 1, At, B1); PG8_BAR; PG8_SCHED;
            PG8_LDB(B0, 1, 0); PG8_LDB(B1, 1, 1); PG8_SCHED; PG8_LDA(At, 1, 0); PG8_STAGE(PG8_SA(0, 1), a2 + hstep, voffA);
            PG8_WAIT_V(8); PG8_WAIT_L(0); PG8_BAR; PG8_MMA(0, 0, At, B0); PG8_MMA(0, 1, At, B1); PG8_BAR; PG8_SCHED;
            PG8_LDA(At, 1, 1); PG8_STAGE(PG8_SB(1, 0), b3, voffB); PG8_STAGE(PG8_SB(1, 1), b3 + hstep, voffB); PG8_STAGE(PG8_SA(1, 0), a3, voffA);
            PG8_WAIT_V(8); PG8_WAIT_L(0); PG8_BAR; PG8_MMA(1, 0, At, B0); PG8_MMA(1, 1, At, B1); PG8_BAR; PG8_SCHED;
            } else {
            PG8_LDB(B0, 0, 0); PG8_SCHED; PG8_LDA(At, 0, 0); PG8_STAGE(PG8_SA(1, 1), a1 + hstep, voffA);
            PG8_WAIT_L(8); PG8_BAR; PG8_WAIT_L(0); PG8_MMA(0, 0, At, B0); PG8_BAR; PG8_SCHED;
            PG8_LDB(B1, 0, 1); PG8_STAGE(PG8_SB(0, 0), b2, voffB);
            PG8_BAR; PG8_WAIT_L(0); PG8_MMA(0, 1, At, B1); PG8_BAR;
            PG8_LDA(At, 0, 1); PG8_STAGE(PG8_SA(0, 0), a2, voffA);
            PG8_BAR; PG8_WAIT_L(0); PG8_MMA(1, 0, At, B0); PG8_BAR; PG8_SCHED;
            PG8_STAGE(PG8_SB(0, 1), b2 + hstep, voffB);
            PG8_WAIT_V(6); PG8_BAR; PG8_MMA(1, 1, At, B1); PG8_BAR;
            PG8_LDB(B0, 1, 0); PG8_SCHED; PG8_LDA(At, 1, 0); PG8_STAGE(PG8_SA(0, 1), a2 + hstep, voffA);
            PG8_WAIT_L(8); PG8_BAR; PG8_WAIT_L(0); PG8_MMA(0, 0, At, B0); PG8_BAR; PG8_SCHED;
            PG8_LDB(B1, 1, 1); PG8_STAGE(PG8_SB(1, 0), b3, voffB);
            PG8_BAR; PG8_WAIT_L(0); PG8_MMA(0, 1, At, B1); PG8_BAR;
            PG8_LDA(At, 1, 1); PG8_STAGE(PG8_SA(1, 0), a3, voffA);
            PG8_BAR; PG8_WAIT_L(0); PG8_MMA(1, 0, At, B0); PG8_BAR; PG8_SCHED;
            PG8_STAGE(PG8_SB(1, 1), b3 + hstep, voffB);
            PG8_WAIT_V(6); PG8_BAR; PG8_MMA(1, 1, At, B1); PG8_BAR;
            }
        }
        if constexpr (ALIGN_EPI) { if (wr == 0) PG8_BAR; }
        if constexpr (!Epi::AFTER_DRAIN) { E(acc, cur, wr, wc, fr, fq); S.done(cur); }
        if (!has_next) break;
#pragma unroll
        for (int a = 0; a < 2; ++a)
#pragma unroll
            for (int b = 0; b < 2; ++b)
#pragma unroll
                for (int m = 0; m < 4; ++m)
#pragma unroll
                    for (int n = 0; n < 2; ++n) acc[a][b][m][n] = (f32x4){0.f, 0.f, 0.f, 0.f};
        cur = nxt; cA = nA; cB = nB; ++ui;
        if constexpr (ALIGN_EPI) { if (wr == 1) PG8_BAR; }
    }
    PG8_WAIT_V(0);
    if constexpr (!ALIGN_EPI) { if (wr == 0) PG8_BAR; }
    PG8_BAR;
    if constexpr (Epi::AFTER_DRAIN) { E.fused(acc, cur, wr, wc, fr, fq, lds, wid, lane); S.done(cur); }
#undef PG8_SA
#undef PG8_SB
#undef PG8_STAGE
#undef PG8_LDA
#undef PG8_LDB
#undef PG8_MMA
#undef PG8_WAIT_V
#undef PG8_WAIT_L
#undef PG8_BAR
#undef PG8_SCHED
}
}
#define GAS __attribute__((address_space(1)))
#define LAS __attribute__((address_space(3)))
typedef unsigned short bf16;
typedef unsigned v4u __attribute__((ext_vector_type(4)));
typedef float f32x4 __attribute__((ext_vector_type(4)));
typedef short bf16x8 __attribute__((ext_vector_type(8)));
typedef GAS unsigned gu32;
typedef GAS unsigned long long gu64;
#define RLX_AGENT __ATOMIC_RELAXED, __HIP_MEMORY_SCOPE_AGENT
#define LDS_WAIT() asm volatile("s_waitcnt lgkmcnt(0)" ::: "memory")
#define VM_WAIT() asm volatile("s_waitcnt vmcnt(0)" ::: "memory")
__device__ __forceinline__ unsigned long long rt() { return __builtin_amdgcn_s_memrealtime(); }
__device__ __forceinline__ unsigned f2bf(float f) { unsigned u = __builtin_bit_cast(unsigned, f); return (u + 0x7fffu + ((u >> 16) & 1u)) >> 16; }
__device__ __forceinline__ unsigned pk2(float lo, float hi) { return f2bf(lo) | (f2bf(hi) << 16); }

#define XB_TMO      128
#define XB_XCNT(j)  (256  + 64 * (j))
#define XB_XSUB(j)  (1280 + 64 * (j))
#define XB_XGEN(j)  (2304 + 64 * (j))
#define XB_TOP      3328
#define XB_TOPGEN   3392
#define XCD_BAR_WORDS 3456
#define XB_SPIN_CAP (1u << 18)

__device__ __forceinline__ unsigned xb_ld(unsigned* p)              { return __hip_atomic_load(p, __ATOMIC_RELAXED, __HIP_MEMORY_SCOPE_AGENT); }
__device__ __forceinline__ unsigned xb_add(unsigned* p, unsigned v) { return __hip_atomic_fetch_add(p, v, __ATOMIC_RELAXED, __HIP_MEMORY_SCOPE_AGENT); }
__device__ __forceinline__ unsigned xb_xcc_id() { return (unsigned)__builtin_amdgcn_s_getreg((3 << 11) | 20) & 0xFu; }
#define XB_SPIN(cond, bar) do { unsigned _sp = 0; while (cond) { __builtin_amdgcn_s_sleep(1); \
    if ((++_sp & 255u) == 0u) { if (xb_ld(&(bar)[XB_TMO])) break; if (_sp > XB_SPIN_CAP) { atomicAdd(&(bar)[XB_TMO], 1u); break; } } } } while (0)

struct XcdBarrier {
    unsigned* bar; unsigned x;
    volatile LAS unsigned* st;
};

__device__ __forceinline__ XcdBarrier xcd_barrier_post(unsigned* bar, volatile LAS unsigned* st) {
    XcdBarrier b; b.bar = bar; b.x = xb_xcc_id(); b.st = st;
    if (threadIdx.x == 0) (void)xb_add(&bar[XB_XCNT(b.x)], 1u);
    return b;
}
__device__ __forceinline__ void xcd_barrier_complete(unsigned* bar, unsigned x, unsigned& nloc, unsigned& nx) {
    const unsigned G = gridDim.x * gridDim.y * gridDim.z;
    unsigned sum, cnt, mine, sp = 0u;
    for (;;) {
        sum = 0u; cnt = 0u; mine = 0u;
#pragma unroll
        for (unsigned j = 0; j < 16; ++j) { const unsigned c = xb_ld(&bar[XB_XCNT(j)]); sum += c; cnt += (c > 0u) ? 1u : 0u; mine = (j == x) ? c : mine; }
        if (sum == G) break;
        __builtin_amdgcn_s_sleep(1);
        if ((++sp & 255u) == 0u) { if (xb_ld(&bar[XB_TMO])) break; if (sp > XB_SPIN_CAP) { atomicAdd(&bar[XB_TMO], 1u); break; } }
    }
    nloc = mine > 0u ? mine : 1u; nx = cnt > 0u ? cnt : 1u;
}

__device__ __forceinline__ void xcd_barrier(const XcdBarrier& b) {
    asm volatile("s_waitcnt vmcnt(0)" ::: "memory");
    __syncthreads();
    if (threadIdx.x == 0) {
        unsigned* bar = b.bar;
        __builtin_amdgcn_s_waitcnt(0);
        unsigned nloc = b.st[0], nx = b.st[1];
        if (nloc == 0u) { xcd_barrier_complete(bar, b.x, nloc, nx); b.st[0] = nloc; b.st[1] = nx; }
        const unsigned old = xb_add(&bar[XB_XSUB(b.x)], 1u);
        const unsigned gen = old / nloc;
        if (old + 1u == (gen + 1u) * nloc) {
            __builtin_amdgcn_fence(__ATOMIC_RELEASE, "agent");
            asm volatile("s_waitcnt vmcnt(0)" ::: "memory");
            const unsigned og = xb_add(&bar[XB_TOP], 1u);
            const unsigned tg = og / nx;
            if (og + 1u == (tg + 1u) * nx) xb_add(&bar[XB_TOPGEN], 1u);
            else XB_SPIN(xb_ld(&bar[XB_TOPGEN]) == tg, bar);
            __builtin_amdgcn_fence(__ATOMIC_ACQUIRE, "agent");
            xb_add(&bar[XB_XGEN(b.x)], 1u);
            asm volatile("s_waitcnt vmcnt(0)" ::: "memory");
        } else {
            XB_SPIN(xb_ld(&bar[XB_XGEN(b.x)]) == gen, bar);
            __builtin_amdgcn_fence(__ATOMIC_ACQUIRE, "agent");
            asm volatile("s_waitcnt vmcnt(0)" ::: "memory");
        }
    }
    __syncthreads();
}
constexpr int BATCH = 2, SEQ = 16384, DM = 1024, TOK = BATCH * SEQ;
constexpr int FF = 2816, NHEAD = 16, HD = 64, NGRP = 4;
constexpr int FOXN = 3088, FOXNP = 3328, NSAN = 2608, NSANP = 2816;
constexpr int NCMP = 1023, NCMPP = 1024, NSELB = 256;
constexpr float DN_ALPHA = 1.4142135623730951f, LN_EPS = 1e-5f, LOG2E = 1.4426950408889634f;
constexpr int NWAVES = 8, NTHREADS = 512;
constexpr int N_PHASES = 19;
#ifndef MK_PER_PHASE
#define MK_PER_PHASE 0
#endif
__device__ const unsigned char T5B[128] = {0, 1, 2, 3, 4, 5, 6, 7, 8, 9, 10, 11, 12, 13, 14, 15, 16, 16, 16, 17, 17, 18, 18, 18, 19, 19, 19, 20, 20, 20, 20, 21, 21, 21, 21, 22, 22, 22, 22, 22, 23, 23, 23, 23, 23, 23, 24, 24, 24, 24, 24, 24, 25, 25, 25, 25, 25, 25, 25, 26, 26, 26, 26, 26, 26, 26, 26, 27, 27, 27, 27, 27, 27, 27, 27, 27, 27, 28, 28, 28, 28, 28, 28, 28, 28, 28, 28, 29, 29, 29, 29, 29, 29, 29, 29, 29, 29, 29, 29, 30, 30, 30, 30, 30, 30, 30, 30, 30, 30, 30, 30, 30, 30, 31, 31, 31, 31, 31, 31, 31, 31, 31, 31, 31, 31, 31, 31, 31};
__device__ __forceinline__ int t5_bucket(int d) { return d >= 113 ? 31 : (int)T5B[d < 0 ? 0 : d]; }

constexpr size_t MiB = 1u << 20;
constexpr size_t WS_CTL = 0, CTL_ZERO_BYTES = 1 * MiB;
constexpr size_t WS_WFOXIN = 2 * MiB, WS_WFOXOUT = 9 * MiB, WS_WNSAIN = 11 * MiB, WS_WNSAOUT = 17 * MiB;
constexpr size_t WS_WFFIN0 = 19 * MiB, WS_WFFIN1 = 30 * MiB, WS_WFFOUT0 = 41 * MiB, WS_WFFOUT1 = 47 * MiB;
constexpr size_t WS_MOD = 53 * MiB;
constexpr size_t WS_CB1 = 53 * MiB + 512 * 1024;
constexpr size_t WS_FLOGIT = 54 * MiB;
constexpr size_t WS_G = 56 * MiB;
constexpr size_t WS_GATES = 58 * MiB;
constexpr size_t WS_KCMP = 64 * MiB, WS_VCMP = 65 * MiB;
constexpr size_t WS_SEL = 66 * MiB;
constexpr size_t WS_HBUF = 70 * MiB;
constexpr size_t WS_R = 134 * MiB;
constexpr size_t WS_OC = 326 * MiB;
constexpr size_t WS_KX = 454 * MiB;
constexpr size_t WS_W1T = 470 * MiB, WS_W2T = 471 * MiB;
constexpr size_t WS_END = 472 * MiB;
constexpr int CW_NRM = 8192;
constexpr int CW_QCTR = 8192 + 256;
constexpr int CW_BAR = 4096;

constexpr int RING_BYTES = 131072, LDSCTL_OFF = RING_BYTES, MISC_OFF = LDSCTL_OFF + 320, LDS_BYTES = 147456;
__device__ __forceinline__ float bf2f(unsigned short u) { return __uint_as_float((unsigned)u << 16); }
__device__ __forceinline__ void bf8_to_f(const v4u w, float* o) {
    o[0] = __uint_as_float(w.x << 16); o[1] = __uint_as_float(w.x & 0xffff0000u); o[2] = __uint_as_float(w.y << 16); o[3] = __uint_as_float(w.y & 0xffff0000u);
    o[4] = __uint_as_float(w.z << 16); o[5] = __uint_as_float(w.z & 0xffff0000u); o[6] = __uint_as_float(w.w << 16); o[7] = __uint_as_float(w.w & 0xffff0000u);
}
__device__ __forceinline__ float wave_sum(float v) {
#pragma unroll
    for (int o = 1; o < 64; o <<= 1) v += __shfl_xor(v, o);
    return v;
}
__device__ __forceinline__ float wave_max(float v) {
#pragma unroll
    for (int o = 1; o < 64; o <<= 1) v = fmaxf(v, __shfl_xor(v, o));
    return v;
}
struct Ctx { int tid, lane, wave, vcu, G; unsigned char* lds; };

__device__ __forceinline__ void tr_item(const float* W, int ldw, int K, bf16* WT, int k0, int nd0, int sc0, int nvalid, float* scr, int lane) {
    const int col = lane & 31;
#pragma unroll 8
    for (int i = 0; i < 32; ++i) { const int kk = 2 * i + (lane >> 5); scr[kk * 33 + col] = col < nvalid ? W[(size_t)(k0 + kk) * ldw + sc0 + col] : 0.f; }
    LDS_WAIT(); asm volatile("" ::: "memory");
    const int c = lane & 7;
#pragma unroll
    for (int j = 0; j < 4; ++j) { const int n = (lane >> 3) + 8 * j; const float* s = scr + (8 * c) * 33 + n;
        v4u o; o.x = pk2(s[0 * 33], s[1 * 33]); o.y = pk2(s[2 * 33], s[3 * 33]); o.z = pk2(s[4 * 33], s[5 * 33]); o.w = pk2(s[6 * 33], s[7 * 33]);
        *(v4u*)(WT + (size_t)(nd0 + n) * K + k0 + 8 * c) = o; }
    LDS_WAIT(); asm volatile("" ::: "memory");
}
__device__ __forceinline__ void p_prep(const Ctx& C, const float* const* in, unsigned char* ws) {
    float* scr = (float*)(C.lds + C.wave * 16384);
    const int gw = C.vcu * NWAVES + C.wave, NGW = C.G * NWAVES;
    constexpr int I_FOXIN = 16 * (FOXNP / 32), I_SQ = 16 * 32, I_NSAIN = 16 * (NSANP / 32), I_FFIN = 16 * (2 * FF / 32), I_FFOUT = (FF / 64) * 32;
    constexpr int I_W1 = 32 * 4, I_W2 = 2 * 2;
    constexpr int NITEMS = I_FOXIN + I_SQ + I_NSAIN + I_SQ + 2 * I_FFIN + 2 * I_FFOUT + 2 * I_W1 + 2 * I_W2;
    for (int it = gw; it < NITEMS; it += NGW) {
        int r = it;
        if (r < I_FOXIN) { const int nb = r % (FOXNP / 32), kb = r / (FOXNP / 32); const int nd0 = 32 * nb; int nv = FOXN - nd0; nv = nv < 0 ? 0 : (nv > 32 ? 32 : nv);
            tr_item(in[6], FOXN, DM, (bf16*)(ws + WS_WFOXIN), 64 * kb, nd0, nd0, nv, scr, C.lane); continue; } r -= I_FOXIN;
        if (r < I_SQ) { const int nb = r % 32, kb = r / 32; tr_item(in[8], DM, DM, (bf16*)(ws + WS_WFOXOUT), 64 * kb, 32 * nb, 32 * nb, 32, scr, C.lane); continue; } r -= I_SQ;
        if (r < I_NSAIN) { const int nb = r % (NSANP / 32), kb = r / (NSANP / 32); const int nd0 = 32 * nb; int nv = NSAN - nd0; nv = nv < 0 ? 0 : (nv > 32 ? 32 : nv);
            tr_item(in[9], NSAN, DM, (bf16*)(ws + WS_WNSAIN), 64 * kb, nd0, nd0, nv, scr, C.lane); continue; } r -= I_NSAIN;
        if (r < I_SQ) { const int nb = r % 32, kb = r / 32; tr_item(in[14], DM, DM, (bf16*)(ws + WS_WNSAOUT), 64 * kb, 32 * nb, 32 * nb, 32, scr, C.lane); continue; } r -= I_SQ;
        if (r < 2 * I_FFIN) { const int l = r / I_FFIN; r -= l * I_FFIN; const int nb = r % (2 * FF / 32), kb = r / (2 * FF / 32); const int nd0 = 32 * nb, tile = nd0 >> 8, j = nd0 & 255;
            const int sc0 = j < 128 ? 128 * tile + j : FF + 128 * tile + (j - 128);
            tr_item(in[16] + (size_t)l * DM * 2 * FF, 2 * FF, DM, (bf16*)(ws + (l ? WS_WFFIN1 : WS_WFFIN0)), 64 * kb, nd0, sc0, 32, scr, C.lane); continue; } r -= 2 * I_FFIN;
        if (r < 2 * I_FFOUT) { const int l = r / I_FFOUT; r -= l * I_FFOUT; const int nb = r % 32, kb = r / 32;
            tr_item(in[17] + (size_t)l * FF * DM, DM, FF, (bf16*)(ws + (l ? WS_WFFOUT1 : WS_WFFOUT0)), 64 * kb, 32 * nb, 32 * nb, 32, scr, C.lane); continue; } r -= 2 * I_FFOUT;
        if (r < 2 * I_W1) { const int kv = r / I_W1; r -= kv * I_W1; const int nb = r % 4, kb = r / 4;
            tr_item(in[12] + (size_t)kv * 2048 * 128, 128, 2048, (bf16*)(ws + WS_W1T) + (size_t)kv * 128 * 2048, 64 * kb, 32 * nb, 32 * nb, 32, scr, C.lane); continue; } r -= 2 * I_W1;
        { const int kv = r / I_W2; r -= kv * I_W2; const int nb = r % 2, kb = r / 2;
            tr_item(in[13] + (size_t)kv * 128 * 64, 64, 128, (bf16*)(ws + WS_W2T) + (size_t)kv * 64 * 128, 64 * kb, 32 * nb, 32 * nb, 32, scr, C.lane); }
    }
    __syncthreads();
    float* cs = (float*)C.lds;
    float* red = cs + 2 * DM;
    for (int i = C.tid; i < BATCH * DM; i += NTHREADS) { const float v = in[1][i]; cs[i] = v / (1.f + __expf(-v)); }
    __syncthreads();
    float* mod = (float*)(ws + WS_MOD);
    for (int task = C.vcu; task < 2 * 96 + 4; task += C.G) {
        float a0 = 0.f, a1 = 0.f;
        if (task < 192) {
            const int l = task / 96, cb = task % 96; const float* w = in[2] + (size_t)l * DM * 6 * DM + (size_t)(128 * C.wave) * 6 * DM + 64 * cb + C.lane;
            const float* c0 = cs + 128 * C.wave; const float* c1 = cs + DM + 128 * C.wave;
#pragma unroll 8
            for (int k = 0; k < 128; ++k) { const float wv = w[(size_t)k * 6 * DM]; a0 += c0[k] * wv; a1 += c1[k] * wv; }
        } else {
            const int kv = (task - 192) >> 1, cb = (task - 192) & 1; const float* pos = in[11] + kv * 2048 + 256 * C.wave; const float* w1 = in[12] + (size_t)kv * 2048 * 128 + (size_t)(256 * C.wave) * 128 + 64 * cb + C.lane;
#pragma unroll 8
            for (int i = 0; i < 256; ++i) a0 += pos[i] * w1[(size_t)i * 128];
        }
        red[(C.wave * 2 + 0) * 64 + C.lane] = a0; red[(C.wave * 2 + 1) * 64 + C.lane] = a1;
        __syncthreads();
        if (C.wave == 0) {
            float s0 = 0.f, s1 = 0.f;
#pragma unroll
            for (int w = 0; w < 8; ++w) { s0 += red[(w * 2 + 0) * 64 + C.lane]; s1 += red[(w * 2 + 1) * 64 + C.lane]; }
            if (task < 192) { const int l = task / 96, cb = task % 96; const float bb = in[3][l * 6 * DM + 64 * cb + C.lane];
                mod[(size_t)(l * BATCH + 0) * 6 * DM + 64 * cb + C.lane] = s0 + bb; mod[(size_t)(l * BATCH + 1) * 6 * DM + 64 * cb + C.lane] = s1 + bb; }
            else { const int kv = (task - 192) >> 1, cb = (task - 192) & 1; ((float*)(ws + WS_CB1))[kv * 128 + 64 * cb + C.lane] = s0; }
        }
        __syncthreads();
    }
}

__device__ __forceinline__ void p_modrows(const Ctx& C, const float* x, const float* modl  , int sh_off, int sc_off, bf16* h) {
    const int gw = C.vcu * NWAVES + C.wave, NGW = C.G * NWAVES;
    for (int m = gw; m < TOK; m += NGW) {
        const int b = m / SEQ; const f32x4* xr = (const f32x4*)(x + (size_t)m * DM) + C.lane;
        const f32x4* sc = (const f32x4*)(modl + b * 6 * DM + sc_off) + C.lane; const f32x4* sh = (const f32x4*)(modl + b * 6 * DM + sh_off) + C.lane;
        unsigned long long* o8 = (unsigned long long*)(h + (size_t)m * DM) + C.lane;
#pragma unroll
        for (int j = 0; j < 4; ++j) { const f32x4 v = xr[64 * j] * (sc[64 * j] + 1.0f) + sh[64 * j];
            o8[64 * j] = (unsigned long long)pk2(v.x, v.y) | ((unsigned long long)pk2(v.z, v.w) << 32); }
    }
}
__device__ __forceinline__ void p_lnrows(const Ctx& C, float* xz, const float* lg, const float* lb, const float* modl, int sh_off, int sc_off, bf16* h) {
    const int gw = C.vcu * NWAVES + C.wave, NGW = C.G * NWAVES;
    for (int m = gw; m < TOK; m += NGW) {
        const int b = m / SEQ; f32x4* xr = (f32x4*)(xz + (size_t)m * DM) + C.lane;
        f32x4 v[4]; float s = 0.f;
#pragma unroll
        for (int j = 0; j < 4; ++j) { v[j] = xr[64 * j]; s += (v[j].x + v[j].y) + (v[j].z + v[j].w); }
        const float mean = wave_sum(s) * (1.f / DM); float s2 = 0.f;
#pragma unroll
        for (int j = 0; j < 4; ++j) { v[j] = v[j] - mean; s2 += (v[j].x * v[j].x + v[j].y * v[j].y) + (v[j].z * v[j].z + v[j].w * v[j].w); }
        const float rstd = 1.f / sqrtf(wave_sum(s2) * (1.f / DM) + LN_EPS);
#pragma unroll
        for (int j = 0; j < 4; ++j) { const f32x4 g = ((const f32x4*)lg)[C.lane + 64 * j], bb = ((const f32x4*)lb)[C.lane + 64 * j]; v[j] = v[j] * rstd * g + bb; xr[64 * j] = v[j]; }
        if (h) {
            const f32x4* sc = (const f32x4*)(modl + b * 6 * DM + sc_off) + C.lane; const f32x4* sh = (const f32x4*)(modl + b * 6 * DM + sh_off) + C.lane;
            unsigned long long* o8 = (unsigned long long*)(h + (size_t)m * DM) + C.lane;
#pragma unroll
            for (int j = 0; j < 4; ++j) { const f32x4 w = v[j] * (sc[64 * j] + 1.0f) + sh[64 * j];
                o8[64 * j] = (unsigned long long)pk2(w.x, w.y) | ((unsigned long long)pk2(w.z, w.w) << 32); }
        }
    }
}

__device__ __forceinline__ void p_scan(const Ctx& C, const float* flogit, const float* bf, float* Gf, bf16* KX, const bf16* Qb, const bf16* Kb, unsigned* nrm) {
    const int gw = C.vcu * NWAVES + C.wave;
    if (gw >= BATCH * NHEAD) {
        const int nw = C.G * NWAVES - BATCH * NHEAD, w = gw - BATCH * NHEAD;
        for (int which = 0; which < 2; ++which)
            for (int bb = 0; bb < BATCH; ++bb) {
                const bf16* src = (which ? Kb : Qb) + (size_t)bb * SEQ * DM; float mx = 0.f;
                for (int it = w; it < SEQ / 4; it += nw) {
                    const v4u* rp = (const v4u*)(src + (size_t)(4 * it) * DM) + C.lane * 8;
                    float sq = 0.f;
#pragma unroll
                    for (int i = 0; i < 8; ++i) { float t8[8]; bf8_to_f(rp[i], t8);
#pragma unroll
                        for (int e = 0; e < 8; ++e) sq += t8[e] * t8[e]; }
                    mx = fmaxf(mx, sq);
                }
                mx = fmaxf(mx, __shfl_xor(mx, 16)); mx = fmaxf(mx, __shfl_xor(mx, 32));
                if (C.lane < 16) atomicMax(nrm + which * 64 + bb * 16 + C.lane, __float_as_uint(mx));
            }
        return;
    }
    const int b = gw / NHEAD, h = gw % NHEAD; const float bias = bf[h];
    double carry = 0.0;
    for (int t0 = 0; t0 < SEQ; t0 += 64) {
        const float xv = flogit[(size_t)(b * SEQ + t0 + C.lane) * 16 + h] + bias;
        float ls = fminf(xv, 0.f) - log1pf(__expf(-fabsf(xv)));
        double v = (double)ls;
#pragma unroll
        for (int o = 1; o < 64; o <<= 1) { const double u = __shfl_up(v, o); if (C.lane >= o) v += u; }
        const double tot = __shfl(v, 63);
        const float gv = (float)((carry + v) * (double)LOG2E);
        Gf[(size_t)gw * SEQ + t0 + C.lane] = gv;
        { const float ng = -gv; const unsigned a0 = f2bf(ng); const float r1 = ng - __uint_as_float(a0 << 16); const unsigned a1 = f2bf(r1); const float r2 = r1 - __uint_as_float(a1 << 16); const unsigned a2 = f2bf(r2);
          v4u* kx = (v4u*)(KX + ((size_t)gw * SEQ + t0 + C.lane) * 16);
          v4u w; w.x = a0 | (a1 << 16); w.y = a2 | (0x3F80u << 16); w.z = 0x3F803F80u; w.w = 0u; kx[0] = w; kx[1] = (v4u){0u, 0u, 0u, 0u}; }
        carry += tot;
    }
}

__device__ __forceinline__ void p_fox_naive(const Ctx& C, const bf16* Q, const bf16* K, const bf16* V, const float* Gf, bf16* O) {
    float* Kt = (float*)C.lds; float* Vt = Kt + 4096; float* Gt = Vt + 4096;
    const int tid = C.tid;
    for (int u = C.vcu; u < 1024; u += C.G) {
        const int bh = u & 31, kk = u >> 5, s = kk & 7, it = kk >> 3;
        const int rb = it == 0 ? s : (it == 1 ? 15 - s : (it == 2 ? 16 + s : 31 - s));
        const int b = bh >> 4, h = bh & 15, row = rb * 512 + tid;
        float q[64], o[64];
        { const v4u* qp = (const v4u*)(Q + (size_t)(b * SEQ + row) * DM + h * HD);
#pragma unroll
          for (int i = 0; i < 8; ++i) bf8_to_f(qp[i], q + 8 * i); }
#pragma unroll
        for (int i = 0; i < 64; ++i) o[i] = 0.f;
        const float gi = Gf[(size_t)bh * SEQ + row];
        float m = -INFINITY, l = 0.f;
        const int jend = (rb + 1) * 512;
        for (int j0 = 0; j0 < jend; j0 += 64) {
            __syncthreads();
            { const int key = tid >> 3, ch = tid & 7; const size_t off = (size_t)(b * SEQ + j0 + key) * DM + h * HD + ch * 8;
              float t8[8]; bf8_to_f(*(const v4u*)(K + off), t8);
              *(f32x4*)(Kt + key * 64 + ch * 8) = (f32x4){t8[0], t8[1], t8[2], t8[3]}; *(f32x4*)(Kt + key * 64 + ch * 8 + 4) = (f32x4){t8[4], t8[5], t8[6], t8[7]};
              bf8_to_f(*(const v4u*)(V + off), t8);
              *(f32x4*)(Vt + key * 64 + ch * 8) = (f32x4){t8[0], t8[1], t8[2], t8[3]}; *(f32x4*)(Vt + key * 64 + ch * 8 + 4) = (f32x4){t8[4], t8[5], t8[6], t8[7]};
              if (tid < 64) Gt[tid] = Gf[(size_t)bh * SEQ + j0 + tid]; }
            __syncthreads();
            if (j0 > row) continue;
            const int kmax = (row - j0) < 63 ? (row - j0) : 63;
            for (int key = 0; key <= kmax; ++key) {
                const f32x4* kr = (const f32x4*)(Kt + key * 64);
                float d0 = 0.f, d1 = 0.f, d2 = 0.f, d3 = 0.f;
#pragma unroll
                for (int i = 0; i < 16; ++i) { const f32x4 kv = kr[i]; d0 += q[4 * i] * kv.x; d1 += q[4 * i + 1] * kv.y; d2 += q[4 * i + 2] * kv.z; d3 += q[4 * i + 3] * kv.w; }
                const float sv = ((d0 + d1) + (d2 + d3)) + (gi - Gt[key]);
                if (sv > m) { const float f = exp2f(m - sv); l *= f;
#pragma unroll
                    for (int i = 0; i < 64; ++i) o[i] *= f;
                    m = sv; }
                const float p = exp2f(sv - m); l += p;
                const f32x4* vr = (const f32x4*)(Vt + key * 64);
#pragma unroll
                for (int i = 0; i < 16; ++i) { const f32x4 vv = vr[i]; o[4 * i] += p * vv.x; o[4 * i + 1] += p * vv.y; o[4 * i + 2] += p * vv.z; o[4 * i + 3] += p * vv.w; }
            }
        }
        const float rl = 1.f / l;
        v4u* op = (v4u*)(O + (size_t)(b * SEQ + row) * DM + h * HD);
#pragma unroll
        for (int i = 0; i < 8; ++i) { v4u w; w.x = pk2(o[8 * i] * rl, o[8 * i + 1] * rl); w.y = pk2(o[8 * i + 2] * rl, o[8 * i + 3] * rl); w.z = pk2(o[8 * i + 4] * rl, o[8 * i + 5] * rl); w.w = pk2(o[8 * i + 6] * rl, o[8 * i + 7] * rl); op[i] = w; }
    }
    __syncthreads();
}

__device__ __forceinline__ void p_compress_naive(const Ctx& C, const bf16* KV  , size_t kv_stride, const float* w1a, const float* w2a, const float* cb1, bf16* kcmp, bf16* vcmp) {
    const int gw = C.vcu * NWAVES + C.wave, NGW = C.G * NWAVES;
    float* hid = (float*)(C.lds + C.wave * 4096);
    for (int u = gw; u < 2 * BATCH * NGRP * 256; u += NGW) {
        const int nq = u & 255, g = (u >> 8) & 3, b = (u >> 10) & 1, kv = u >> 11;
        const bf16* src = KV + (size_t)kv * kv_stride + (size_t)b * SEQ * 256 + g * 64;
        const float* w1 = w1a + (size_t)kv * 2048 * 128; const float* w2 = w2a + (size_t)kv * 128 * 64;
        float a0[4], a1[4];
#pragma unroll
        for (int j = 0; j < 4; ++j) { a0[j] = cb1[kv * 128 + C.lane]; a1[j] = cb1[kv * 128 + 64 + C.lane]; }
        const int n0 = nq * 4;
        for (int i = 0; i < 2048; ++i) {
            const float wa = w1[(size_t)i * 128 + C.lane], wb = w1[(size_t)i * 128 + 64 + C.lane];
#pragma unroll
            for (int j = 0; j < 4; ++j) { const int n = n0 + j; const int tok = 16 * n + (i >> 6);
                const float xv = (n < NCMP) ? bf2f(src[(size_t)tok * 256 + (i & 63)]) : 0.f;
                a0[j] += xv * wa; a1[j] += xv * wb; }
        }
#pragma unroll
        for (int j = 0; j < 4; ++j) { hid[j * 128 + C.lane] = a0[j] / (1.f + __expf(-a0[j])); hid[j * 128 + 64 + C.lane] = a1[j] / (1.f + __expf(-a1[j])); }
        LDS_WAIT(); asm volatile("" ::: "memory");
        float oo[4] = {0.f, 0.f, 0.f, 0.f};
        for (int c = 0; c < 128; ++c) { const float w = w2[c * 64 + C.lane];
#pragma unroll
            for (int j = 0; j < 4; ++j) oo[j] += hid[j * 128 + c] * w; }
        bf16* dst = (kv ? vcmp : kcmp) + (size_t)((b * NGRP + g) * NCMPP) * 64;
#pragma unroll
        for (int j = 0; j < 4; ++j) { const int n = n0 + j; dst[(size_t)n * 64 + C.lane] = (n < NCMP) ? (bf16)f2bf(oo[j]) : (bf16)0; }
        LDS_WAIT(); asm volatile("" ::: "memory");
    }
}

template <int MODE  >
__device__ __forceinline__ void wave_attn(const float (&q)[64], int t, int nchunks, int nvis, const int* bl, const bf16* Kb, const bf16* Vb, int pitch, const float* relh  ,
                                          float* sc, float& l_out, float& o_out, int lane) {
    float mx = -INFINITY;
    for (int c = 0; c < nchunks; ++c) {
        const int slot = 64 * c + lane; int key, dist; bool valid;
        if (MODE == 0) { key = slot; valid = slot < nvis; dist = t - (16 * slot + 31); }
        else if (MODE == 1) { key = 64 * bl[c] + lane; valid = key <= t; dist = t - key; }
        else { key = t - 511 + slot; valid = key >= 0; dist = t - key; }
        float s = -INFINITY;
        if (valid) {
            const v4u* kp = (const v4u*)(Kb + (size_t)key * pitch); float d0 = 0.f, d1 = 0.f;
#pragma unroll
            for (int i = 0; i < 8; ++i) { float k8[8]; bf8_to_f(kp[i], k8);
#pragma unroll
                for (int e = 0; e < 8; e += 2) { d0 += q[8 * i + e] * k8[e]; d1 += q[8 * i + e + 1] * k8[e + 1]; } }
            s = (d0 + d1) + relh[16 * t5_bucket(dist)] * LOG2E;
        }
        sc[slot] = s; mx = fmaxf(mx, s);
    }
    mx = wave_max(mx);
    float ls = 0.f;
    if (mx == -INFINITY) { l_out = 0.f; o_out = 0.f; for (int c = 0; c < nchunks; ++c) sc[64 * c + lane] = 0.f; LDS_WAIT(); return; }
    for (int c = 0; c < nchunks; ++c) { const int slot = 64 * c + lane; const float s = sc[slot]; const float p = (s == -INFINITY) ? 0.f : exp2f(s - mx); sc[slot] = p; ls += p; }
    l_out = wave_sum(ls);
    LDS_WAIT(); asm volatile("" ::: "memory");
    float o = 0.f;
    const int ntot = (MODE == 0) ? nvis : 64 * nchunks;
    for (int slot = 0; slot < ntot; ++slot) {
        const float p = sc[slot];
        if (p != 0.f) { int key; if (MODE == 0) key = slot; else if (MODE == 1) key = 64 * bl[slot >> 6] + (slot & 63); else key = t - 511 + slot;
            o += p * bf2f(Vb[(size_t)key * pitch + lane]); }
    }
    o_out = o;
}
__device__ __forceinline__ void load_q(const bf16* Qrow, float* qs, float (&q)[64], int lane) {
    qs[lane] = bf2f(Qrow[lane]); LDS_WAIT(); asm volatile("" ::: "memory");
#pragma unroll
    for (int i = 0; i < 16; ++i) { const f32x4 v = ((const f32x4*)qs)[i]; q[4 * i] = v.x; q[4 * i + 1] = v.y; q[4 * i + 2] = v.z; q[4 * i + 3] = v.w; }
    asm volatile("" ::: "memory");
}
__device__ __forceinline__ void p_nsa_cmp_naive(const Ctx& C, const bf16* Q, const bf16* kcmp, const bf16* vcmp, const float* relb, float* OC, unsigned* SEL) {
    const int gw = C.vcu * NWAVES + C.wave, NGW = C.G * NWAVES, lane = C.lane;
    float* sc = (float*)(C.lds + C.wave * 10240); float* imp = sc + 1024; float* qs = imp + 1024;
    for (int u = gw; u < TOK * NGRP; u += NGW) {
        const int g = u & 3, tok = u >> 2, b = tok / SEQ, t = tok % SEQ;
        int nvis = t >= 31 ? ((t - 31) / 16 + 1) : 0; if (nvis > NCMP) nvis = NCMP;
        const int nch = (nvis + 63) >> 6;
        for (int i = lane; i < 1024; i += 64) imp[i] = 0.f;
        const bf16* Kb = kcmp + (size_t)((b * NGRP + g) * NCMPP) * 64; const bf16* Vb = vcmp + (size_t)((b * NGRP + g) * NCMPP) * 64;
        for (int hh = 0; hh < 4; ++hh) {
            const int head = g * 4 + hh; float q[64];
            load_q(Q + (size_t)tok * DM + head * HD, qs, q, lane);
            float l, o;
            wave_attn<0>(q, t, nch, nvis, nullptr, Kb, Vb, 64, relb + head, sc, l, o, lane);
            const float rl = l > 0.f ? 1.f / fmaxf(l, 1e-30f) : 0.f;
            OC[(size_t)tok * DM + head * HD + lane] = o * rl;
            for (int c = 0; c < nch; ++c) imp[64 * c + lane] += sc[64 * c + lane] * rl;
            LDS_WAIT(); asm volatile("" ::: "memory");
        }
        const int cur = t >> 6;
        float val[4];
#pragma unroll
        for (int k = 0; k < 4; ++k) { const int j = lane + 64 * k; float v = 0.f;
#pragma unroll
            for (int a = -1; a <= 3; ++a) { const int idx = 4 * j + a; if (idx >= 0 && idx < nvis) v += imp[idx]; }
            const bool forced = (j == 0) || (j == cur) || (j == cur - 1);
            val[k] = forced ? 1e9f : (j <= cur ? v : -1e30f); }
        unsigned mw[8];
#pragma unroll
        for (int w = 0; w < 8; ++w) mw[w] = 0u;
        for (int r = 0; r < 16; ++r) {
            float bv = val[0]; int bj = lane;
#pragma unroll
            for (int k = 1; k < 4; ++k) if (val[k] > bv) { bv = val[k]; bj = lane + 64 * k; }
#pragma unroll
            for (int o = 1; o < 64; o <<= 1) { const float ov = __shfl_xor(bv, o); const int oj = __shfl_xor(bj, o); if (ov > bv || (ov == bv && oj < bj)) { bv = ov; bj = oj; } }
            if (bv > -0.5e30f) {
#pragma unroll
                for (int w = 0; w < 8; ++w) mw[w] |= (w == (bj >> 5)) ? (1u << (bj & 31)) : 0u;
            }
            if ((bj & 63) == lane) {
#pragma unroll
                for (int k = 0; k < 4; ++k) if (k == (bj >> 6)) val[k] = -3e38f;
            }
        }
        if (lane < 8) { unsigned w = mw[0];
#pragma unroll
            for (int k = 1; k < 8; ++k) if (lane == k) w = mw[k];
            SEL[(size_t)u * 8 + lane] = w; }
    }
}
__device__ __forceinline__ void p_nsa_selwin_naive(const Ctx& C, const bf16* Q, const bf16* KVb, size_t kv_stride, const float* relb, const float* OC, const unsigned* SEL, const float* gates, bf16* O) {
    const int gw = C.vcu * NWAVES + C.wave, NGW = C.G * NWAVES, lane = C.lane;
    float* sc = (float*)(C.lds + C.wave * 10240); int* bl = (int*)(sc + 1024); float* qs = sc + 1024 + 64;
    const bf16* KS = KVb + 2 * kv_stride; const bf16* VS = KVb + 3 * kv_stride; const bf16* KW = KVb + 4 * kv_stride; const bf16* VW = KVb + 5 * kv_stride;
    for (int u = gw; u < TOK * NGRP; u += NGW) {
        const int g = u & 3, tok = u >> 2, b = tok / SEQ, t = tok % SEQ;
        int nsel = 0;
        for (int w = 0; w < 8; ++w) { unsigned mwv = SEL[(size_t)u * 8 + w]; while (mwv) { const int bit = __builtin_ctz(mwv); mwv &= mwv - 1; if (lane == 0) bl[nsel] = 32 * w + bit; ++nsel; } }
        LDS_WAIT(); asm volatile("" ::: "memory");
        const size_t boff = (size_t)b * SEQ * 256 + g * 64;
        for (int hh = 0; hh < 4; ++hh) {
            const int head = g * 4 + hh; float q[64];
            load_q(Q + (size_t)tok * DM + head * HD, qs, q, lane);
            float ls, os, lw, ow;
            wave_attn<1>(q, t, nsel, 0, bl, KS + boff, VS + boff, 256, relb + head, sc, ls, os, lane);
            LDS_WAIT(); asm volatile("" ::: "memory");
            wave_attn<2>(q, t, 8, 0, nullptr, KW + boff, VW + boff, 256, relb + head, sc, lw, ow, lane);
            LDS_WAIT(); asm volatile("" ::: "memory");
            const float* gt = gates + (size_t)tok * 48;
            const float oc = OC[(size_t)tok * DM + head * HD + lane];
            const float outv = gt[head] * oc + gt[16 + head] * (os / fmaxf(ls, 1e-30f)) + gt[32 + head] * (ow / fmaxf(lw, 1e-30f));
            O[(size_t)tok * DM + head * HD + lane] = (bf16)f2bf(outv);
        }
    }
}
namespace fa {
using bf16x8 = __attribute__((ext_vector_type(8))) short;
using s16x4 = __attribute__((ext_vector_type(4))) short;
using f32x16 = __attribute__((ext_vector_type(16))) float;
using u32x4 = __attribute__((ext_vector_type(4))) unsigned;
typedef __attribute__((address_space(3))) const char* lds_cptr;
constexpr int SLOTB = 8192, KXSLOT = 2048;
constexpr int L_K = 0, L_V = 3 * SLOTB, L_KX = 6 * SLOTB, L_WS = L_KX + 3 * KXSLOT, L_OST = L_WS + 8 * 256, L_END = L_OST + 8 * 4096;
#define FA_SBAR() __builtin_amdgcn_sched_barrier(0)
#define FA_MFMA(a, b, c) __builtin_amdgcn_mfma_f32_32x32x16_bf16(a, b, c, 0, 0, 0)
#define FA_WAIT_BAR(N) asm volatile("s_waitcnt vmcnt(" #N ") lgkmcnt(0)\n\ts_barrier" ::: "memory")
__device__ __forceinline__ int crow(int r, int hi) { return (r & 3) + 8 * (r >> 2) + 4 * hi; }
__device__ __forceinline__ void glds16(const void* g, unsigned lds_dst) { unsigned keep;
    asm volatile("s_mov_b32 %0, m0\n\ts_mov_b32 m0, %2\n\ts_nop 0\n\tglobal_load_lds_dwordx4 %1, off\n\ts_mov_b32 m0, %0" : "=&s"(keep) : "v"(g), "s"(lds_dst) : "memory"); }
__device__ __forceinline__ void glds4(const void* g, unsigned lds_dst) { unsigned keep;
    asm volatile("s_mov_b32 %0, m0\n\ts_mov_b32 m0, %2\n\ts_nop 0\n\tglobal_load_lds_dword %1, off\n\ts_mov_b32 m0, %0" : "=&s"(keep) : "v"(g), "s"(lds_dst) : "memory"); }
typedef float f32x2_t __attribute__((ext_vector_type(2))); typedef __bf16 bf16x2_t __attribute__((ext_vector_type(2)));
__device__ __forceinline__ unsigned cvtpk(float lo, float hi) { f32x2_t v = {lo, hi}; bf16x2_t b = __builtin_convertvector(v, bf16x2_t); return __builtin_bit_cast(unsigned, b); }
#define FA_MX3(a, b, c) __builtin_fmaxf(__builtin_fmaxf((a), (b)), (c))
__device__ __forceinline__ float rowmax(const f32x16& p0, const f32x16& p1) {
    float a = FA_MX3(p0[0], p0[1], p1[0]), b = FA_MX3(p0[2], p0[3], p1[1]); a = FA_MX3(a, p1[2], p1[3]);
#pragma unroll
    for (int r = 4; r < 16; r += 4) { a = FA_MX3(a, p0[r], p0[r + 1]); b = FA_MX3(b, p0[r + 2], p0[r + 3]); a = FA_MX3(a, p1[r], p1[r + 1]); b = FA_MX3(b, p1[r + 2], p1[r + 3]); }
    float m = __builtin_fmaxf(a, b); auto rr = __builtin_amdgcn_permlane32_swap(__float_as_uint(m), __float_as_uint(m), false, false);
    return __builtin_fmaxf(__uint_as_float(rr[0]), __uint_as_float(rr[1])); }
__device__ __forceinline__ void qkt_acc(f32x16& p0, f32x16& p1, lds_cptr kp, const bf16x8* qr) {
#pragma unroll
    for (int d0 = 0; d0 < 4; ++d0) {
        const bf16x8 b0 = *(const __attribute__((address_space(3))) bf16x8*)(kp + d0 * 2048);
        const bf16x8 b1 = *(const __attribute__((address_space(3))) bf16x8*)(kp + d0 * 2048 + 512);
        p0 = FA_MFMA(b0, qr[d0], p0); p1 = FA_MFMA(b1, qr[d0], p1); }
}
__device__ __forceinline__ void pv(f32x16* o, int vb, bf16x8 pa0, bf16x8 pa1, bf16x8 pa2, bf16x8 pa3) {
#pragma unroll
    for (int d0 = 0; d0 < 2; ++d0) { s16x4 lo[4], hi[4];
#pragma unroll
        for (int ks = 0; ks < 4; ++ks) {
            asm volatile("ds_read_b64_tr_b16 %0,%1 offset:%c2" : "=&v"(lo[ks]) : "v"(vb), "i"(d0 * 4096 + ks * 1024) : "memory");
            asm volatile("ds_read_b64_tr_b16 %0,%1 offset:%c2" : "=&v"(hi[ks]) : "v"(vb), "i"(d0 * 4096 + ks * 1024 + 512) : "memory"); }
        asm volatile("s_waitcnt lgkmcnt(0)" ::: "memory"); FA_SBAR();
#define FA_PK(k) (bf16x8){lo[k][0], lo[k][1], lo[k][2], lo[k][3], hi[k][0], hi[k][1], hi[k][2], hi[k][3]}
        o[d0] = FA_MFMA(pa0, FA_PK(0), o[d0]); o[d0] = FA_MFMA(pa1, FA_PK(1), o[d0]); o[d0] = FA_MFMA(pa2, FA_PK(2), o[d0]); o[d0] = FA_MFMA(pa3, FA_PK(3), o[d0]);
#undef FA_PK
    }
}
template <int THRL>
__device__ __forceinline__ void softmax_pv(f32x16& p0, f32x16& p1, f32x16* o, float& mhat, float& l_reg, bool& moved, float* wsf, int vb, int r32, int hi) {
    const float rm = rowmax(p0, p1);
    moved = false;
    if (__any(rm > (float)THRL)) {
        const float dl = __builtin_fmaxf(rm, 0.f); mhat += dl;
#pragma unroll
        for (int r = 0; r < 16; ++r) { p0[r] -= dl; p1[r] -= dl; }
        const float f = __builtin_amdgcn_exp2f(-dl); l_reg *= f; if (hi == 0) wsf[r32] = f;
        asm volatile("s_waitcnt lgkmcnt(0)" ::: "memory");
#pragma unroll
        for (int d = 0; d < 2; ++d)
#pragma unroll
            for (int r = 0; r < 16; ++r) o[d][r] *= wsf[crow(r, hi)];
        moved = true;
    }
    float s0 = 0.f, s1 = 0.f;
#pragma unroll
    for (int r = 0; r < 16; ++r) { p0[r] = __builtin_amdgcn_exp2f(p0[r]); p1[r] = __builtin_amdgcn_exp2f(p1[r]); s0 += p0[r]; s1 += p1[r]; }
    l_reg += s0 + s1;
    u32x4 pw0 = {cvtpk(p0[0], p0[1]), cvtpk(p0[2], p0[3]), cvtpk(p0[4], p0[5]), cvtpk(p0[6], p0[7])};
    u32x4 pw1 = {cvtpk(p0[8], p0[9]), cvtpk(p0[10], p0[11]), cvtpk(p0[12], p0[13]), cvtpk(p0[14], p0[15])};
    u32x4 pw2 = {cvtpk(p1[0], p1[1]), cvtpk(p1[2], p1[3]), cvtpk(p1[4], p1[5]), cvtpk(p1[6], p1[7])};
    u32x4 pw3 = {cvtpk(p1[8], p1[9]), cvtpk(p1[10], p1[11]), cvtpk(p1[12], p1[13]), cvtpk(p1[14], p1[15])};
    FA_SBAR();
    pv(o, vb, __builtin_bit_cast(bf16x8, pw0), __builtin_bit_cast(bf16x8, pw1), __builtin_bit_cast(bf16x8, pw2), __builtin_bit_cast(bf16x8, pw3));
}
__device__ __forceinline__ unsigned short bfr(float x) { unsigned u = __float_as_uint(x); return (unsigned short)((u + 0x7fffu + ((u >> 16) & 1u)) >> 16); }
__device__ __forceinline__ float bfv(unsigned short h) { return __uint_as_float((unsigned)h << 16); }
__device__ __forceinline__ void split3(float x, unsigned short& a, unsigned short& b, unsigned short& c) { a = bfr(x); const float r1 = x - bfv(a); b = bfr(r1); c = bfr(r1 - bfv(b)); }

template <int THRL>
__device__ __forceinline__ void fox_unit(int b, int h, int qb, int tfirst, const bf16* Q, const bf16* __restrict__ K, const bf16* __restrict__ V, const bf16* __restrict__ KX, const float* __restrict__ Gf, bf16* O, char* shm) {
    int tid = threadIdx.x; asm volatile("" : "+v"(tid));
    const int lane = tid & 63, r32 = lane & 31, hi = lane >> 5; const int wid = __builtin_amdgcn_readfirstlane(tid >> 6);
    const long rowbase = (long)b * SEQ; const int q0 = qb * 256, NT = 4 * qb + 4;
    const bf16* Qw = Q + (rowbase + q0 + wid * 32) * DM + h * HD;
    const bf16* Kh = K + rowbase * DM + h * HD; const bf16* Vh = V + rowbase * DM + h * HD;
    const float* Gh = Gf + (size_t)(b * NHEAD + h) * SEQ;
    const char* KXh = (const char*)(KX + (size_t)(b * NHEAD + h) * SEQ * 16);
    const unsigned lds0 = (unsigned)(uintptr_t)shm; float* wsf = (float*)(shm + L_WS) + wid * 64;
    const bf16* ksrc = Kh + (long)lane * DM + wid * 8;
    const bf16* vsrc = Vh + (long)(16 * (wid & 3) + (lane >> 2)) * DM + (wid >> 2) * 32 + (lane & 3) * 8;
    const char* xsrc = KXh + wid * 256 + lane * 4;
    const unsigned kdst = lds0 + L_K + wid * 1024, vdst = lds0 + L_V + wid * 1024, xdst = lds0 + L_KX + wid * 256;
#define DMA_T(t, sl) do { glds16(ksrc + (long)(t) * 64 * DM, (unsigned)__builtin_amdgcn_readfirstlane(kdst + (sl) * SLOTB)); \
                          glds16(vsrc + (long)(t) * 64 * DM, (unsigned)__builtin_amdgcn_readfirstlane(vdst + (sl) * SLOTB)); \
                          glds4(xsrc + (long)(t) * 2048, (unsigned)__builtin_amdgcn_readfirstlane(xdst + (sl) * KXSLOT)); } while (0)
    const int vb0 = (int)(lds0 + L_V) + ((lane >> 4) & 1) * 32 + (lane & 3) * 8 + (4 * hi + ((lane & 15) >> 2)) * 64;
    const lds_cptr shm3 = (lds_cptr)shm; const lds_cptr kp0 = shm3 + L_K + hi * 1024 + r32 * 16; const lds_cptr xp0 = shm3 + L_KX + r32 * 32 + hi * 16;
    DMA_T(tfirst, 0); DMA_T(tfirst + 1, 1);
    bf16x8 qr[4];
#pragma unroll
    for (int d0 = 0; d0 < 4; ++d0) qr[d0] = *reinterpret_cast<const bf16x8*>(&Qw[(long)r32 * DM + d0 * 16 + hi * 8]);
    const float anchor = Gh[q0]; const float gi_rel = Gh[q0 + wid * 32 + r32] - anchor;
    bf16x8 qx;
    { unsigned short a0, a1, a2; split3(anchor, a0, a1, a2); const short one = (short)0x3F80;
      qx = (bf16x8){one, one, one, (short)a0, (short)a1, (short)a2, 0, 0}; if (hi) qx = (bf16x8){0, 0, 0, 0, 0, 0, 0, 0}; }
    float mhat = 0.f, l_reg = 0.f; f32x16 o[2]; o[0] = f32x16{}; o[1] = f32x16{};
    const int qrel = wid * 32 + r32;
    int sl = 0;
    for (int t = tfirst; t < NT; ++t) {
        if (t + 1 < NT) { FA_WAIT_BAR(3); } else { FA_WAIT_BAR(0); }
        if (t + 2 < NT) { const int s2 = sl >= 1 ? sl - 1 : 2; DMA_T(t + 2, s2); }
        f32x16 p0, p1; const float c0 = gi_rel - mhat;
#pragma unroll
        for (int r = 0; r < 16; ++r) { p0[r] = c0; p1[r] = c0; }
        { const bf16x8 x0 = *(const __attribute__((address_space(3))) bf16x8*)(xp0 + sl * KXSLOT); const bf16x8 x1 = *(const __attribute__((address_space(3))) bf16x8*)(xp0 + sl * KXSLOT + 1024);
          p0 = FA_MFMA(x0, qx, p0); p1 = FA_MFMA(x1, qx, p1); }
        qkt_acc(p0, p1, kp0 + sl * SLOTB, qr);
        { const int jb = t - (NT - 4);
          if (jb >= 0) { const int kb = 64 * jb + 4 * hi;
#pragma unroll
              for (int r = 0; r < 16; ++r) { const int kv = kb + (r & 3) + 8 * (r >> 2); if (kv > qrel) p0[r] = -INFINITY; if (kv + 32 > qrel) p1[r] = -INFINITY; } } }
        bool moved;
        softmax_pv<THRL>(p0, p1, o, mhat, l_reg, moved, wsf, vb0 + sl * SLOTB, r32, hi);
        sl = sl == 2 ? 0 : sl + 1;
    }
    { auto rr = __builtin_amdgcn_permlane32_swap(__float_as_uint(l_reg), __float_as_uint(l_reg), false, false); l_reg = __uint_as_float(rr[0]) + __uint_as_float(rr[1]); }
    if (hi == 0) wsf[32 + r32] = l_reg; asm volatile("s_waitcnt lgkmcnt(0)" ::: "memory");
    float rli[16];
#pragma unroll
    for (int r = 0; r < 16; ++r) rli[r] = __builtin_amdgcn_rcpf(wsf[32 + crow(r, hi)]);
    bf16* Ow = O + (rowbase + q0 + wid * 32) * DM + h * HD;
    { unsigned short* stg = (unsigned short*)(shm + L_OST) + wid * 2048;
#pragma unroll
      for (int r = 0; r < 16; ++r) { const int orow = crow(r, hi);
#pragma unroll
          for (int d0 = 0; d0 < 2; ++d0) stg[orow * 64 + d0 * 32 + r32] = bfr(o[d0][r] * rli[r]); }
      asm volatile("s_waitcnt lgkmcnt(0)" ::: "memory");
#pragma unroll
      for (int i = 0; i < 4; ++i) { const int row = i * 8 + (lane >> 3), ch = lane & 7; const u32x4 v = *(const u32x4*)(stg + row * 64 + ch * 8); *(u32x4*)(Ow + (long)row * DM + ch * 8) = v; } }
    asm volatile("s_waitcnt lgkmcnt(0)\n\ts_barrier" ::: "memory");
#undef DMA_T
}
constexpr int L_TF = L_END;
__device__ __forceinline__ void fox_phase(const Ctx& C, const bf16* Q, const bf16* K, const bf16* V, const bf16* KX, const float* Gf, bf16* O, const unsigned* nrm, unsigned* qctr, volatile LAS unsigned* qslot) {
    unsigned char* tf = (unsigned char*)C.lds + L_TF;
    for (int e = C.tid; e < 2048; e += NTHREADS) {
        const int bh = e >> 6, qb = e & 63; const float* Gh = Gf + (size_t)bh * SEQ;
        const float bq = sqrtf(__uint_as_float(nrm[bh])) * sqrtf(__uint_as_float(nrm[64 + bh])) * 1.001f + 0.01f;
        const float lim = Gh[256 * qb] + bq + 140.f;
        int lo = 0, hi = 4 * qb;
        while (lo < hi) { const int mid = (lo + hi) >> 1; if (Gh[64 * mid + 63] <= lim) hi = mid; else lo = mid + 1; }
        tf[e] = (unsigned char)lo;
    }
    __syncthreads();
    for (;;) {
        if (C.tid == 0) *qslot = atomicAdd(qctr, 1u);
        __syncthreads();
        const unsigned u = *qslot;
        if (u >= 2048u) break;
        const int h = 15 - (int)(u >> 7), b = (int)(u >> 6) & 1, qb = 63 - (int)(u & 63);
        const int tfirst = tf[(b * 16 + h) * 64 + qb];
        fox_unit<8>(b, h, qb, tfirst, Q, K, V, KX, Gf, O, (char*)C.lds);
    }
    __syncthreads();
}
}
namespace fa {
constexpr int L_SEL = L_KX, L_BT = L_KX + 2048, L_IMP = L_OST;
static_assert(L_IMP + 65536 <= 131072, "NSA LDS map");
typedef __attribute__((address_space(3))) float lds_f32;
typedef __attribute__((address_space(3))) unsigned lds_u32;

template <int KIND  >
__device__ __forceinline__ void fix_tile(f32x16& p0, f32x16& p1, int key0, int t, const lds_f32* btl, int hi) {
#pragma unroll
    for (int r = 0; r < 16; ++r) {
#pragma unroll
        for (int hf = 0; hf < 2; ++hf) {
            const int key = key0 + (r & 3) + 8 * (r >> 2) + 4 * hi + 32 * hf;
            const int dist = KIND == 0 ? t - (16 * key + 31) : t - key;
            const bool valid = dist >= 0 && (KIND != 2 || dist < 512);
            int dc = dist < 0 ? 0 : dist; dc = dc > 127 ? 127 : dc;
            const float corr = btl[dc];
            if (hf) p1[r] = valid ? p1[r] + corr : -INFINITY; else p0[r] = valid ? p0[r] + corr : -INFINITY;
        }
    }
}

struct NsaArgs { const bf16* Q; const bf16* KV6; size_t kvs; const bf16* kcmp; const bf16* vcmp; const float* relb; const float* gates; bf16* O; };

template <int THRL>
__device__ __forceinline__ void nsa_unit(int b, int g, int tb, const NsaArgs& A, char* shm) {
    int tid = threadIdx.x; asm volatile("" : "+v"(tid));
    const int lane = tid & 63, r32 = lane & 31, hi = lane >> 5; const int wid = __builtin_amdgcn_readfirstlane(tid >> 6);
    const int t0 = tb * 64, tokl = wid * 8 + (r32 & 7), t = t0 + tokl, hl = r32 >> 3, head = 4 * g + hl;
    const long tokrow = (long)b * SEQ + t;
    const unsigned lds0 = (unsigned)(uintptr_t)shm; float* wsf = (float*)(shm + L_WS) + wid * 64;
    const lds_cptr shm3 = (lds_cptr)shm; const lds_cptr kp0 = shm3 + L_K + hi * 1024 + r32 * 16;
    const int vb0 = (int)(lds0 + L_V) + ((lane >> 4) & 1) * 32 + (lane & 3) * 8 + (4 * hi + ((lane & 15) >> 2)) * 64;
    const unsigned kdst = lds0 + L_K + wid * 1024, vdst = lds0 + L_V + wid * 1024;
    lds_f32* bt = (lds_f32*)(shm3 + L_BT); const lds_f32* btl = bt + hl * 128;
    lds_f32* imp = (lds_f32*)(shm3 + L_IMP); lds_u32* selm = (lds_u32*)(shm3 + L_SEL);
    { const int e = tid; const int hh = e >> 7, d = e & 127; const int hd = 4 * g + hh;
      bt[e] = d < 113 ? (A.relb[(int)T5B[d] * 16 + hd] - A.relb[31 * 16 + hd]) * LOG2E : 0.f; }
    const float b31 = A.relb[31 * 16 + head] * LOG2E;
    bf16x8 qr[4];
    { const bf16* Qw = A.Q + tokrow * DM + head * HD;
#pragma unroll
      for (int d0 = 0; d0 < 4; ++d0) qr[d0] = *reinterpret_cast<const bf16x8*>(&Qw[d0 * 16 + hi * 8]); }
    const float g0 = A.gates[tokrow * 48 + head], g1 = A.gates[tokrow * 48 + 16 + head], g2 = A.gates[tokrow * 48 + 32 + head];
    lds_f32* accl = (lds_f32*)(shm3 + L_IMP) + wid * 2048;
    f32x16 o[2]; float mhat, l_reg;
    const bf16* ksrc; const bf16* vsrc; long tstep;
#define NSA_SRC(Kh, Vh, pitch) do { ksrc = (Kh) + (long)lane * (pitch) + wid * 8; vsrc = (Vh) + (long)(16 * (wid & 3) + (lane >> 2)) * (pitch) + (wid >> 2) * 32 + (lane & 3) * 8; tstep = 64L * (pitch); } while (0)
#define NSA_DMA(tile, sl) do { glds16(ksrc + (long)(tile) * tstep, (unsigned)__builtin_amdgcn_readfirstlane(kdst + (sl) * SLOTB)); \
                               glds16(vsrc + (long)(tile) * tstep, (unsigned)__builtin_amdgcn_readfirstlane(vdst + (sl) * SLOTB)); } while (0)
#define NSA_LOOP(ta, te, ...) do { const int ta_ = (ta), te_ = (te); \
        NSA_DMA(ta_, 0); if (ta_ + 1 < te_) NSA_DMA(ta_ + 1, 1); \
        int sl = 0; \
        for (int tile = ta_; tile < te_; ++tile) { \
            if (tile + 1 < te_) { FA_WAIT_BAR(2); } else { FA_WAIT_BAR(0); } \
            if (tile + 2 < te_) { const int s2 = sl >= 1 ? sl - 1 : 2; NSA_DMA(tile + 2, s2); } \
            __VA_ARGS__ \
            sl = sl == 2 ? 0 : sl + 1; } \
        asm volatile("s_waitcnt lgkmcnt(0)\n\ts_barrier" ::: "memory"); } while (0)
#define NSA_FILL(c0v) do { const float c0_ = (c0v); _Pragma("unroll") for (int r = 0; r < 16; ++r) { p0[r] = c0_; p1[r] = c0_; } } while (0)
#define NSA_ACC(fac, FIRST) do { if (hi == 0) wsf[32 + r32] = (fac); asm volatile("s_waitcnt lgkmcnt(0)" ::: "memory"); \
        _Pragma("unroll") for (int d = 0; d < 2; ++d) _Pragma("unroll") for (int r = 0; r < 16; ++r) { lds_f32* a_ = accl + crow(r, hi) * 64 + d * 32 + r32; \
            const float v_ = o[d][r] * wsf[32 + crow(r, hi)]; *a_ = (FIRST) ? v_ : *a_ + v_; } \
        asm volatile("s_waitcnt lgkmcnt(0)" ::: "memory"); } while (0)

    const int nvmax = (4 * tb + 3) > NCMP ? NCMP : (4 * tb + 3);
    const int NTc = (nvmax + 63) >> 6;
    const int cnear = (4 * tb - 9) < 0 ? 0 : ((4 * tb - 9) >> 6);
    const bf16* Kc = A.kcmp + (size_t)((b * NGRP + g) * NCMPP) * 64; const bf16* Vc = A.vcmp + (size_t)((b * NGRP + g) * NCMPP) * 64;
    NSA_SRC(Kc, Vc, 64);
    mhat = 0.f; l_reg = 0.f;
    NSA_LOOP(0, NTc, {
        f32x16 p0, p1; NSA_FILL(b31 - mhat);
        qkt_acc(p0, p1, kp0 + sl * SLOTB, qr);
        if (tile >= cnear) fix_tile<0>(p0, p1, 64 * tile, t, btl, hi);
        const float rm = rowmax(p0, p1);
        if (__any(rm > 0.f)) { const float dl = __builtin_fmaxf(rm, 0.f); mhat += dl;
            _Pragma("unroll") for (int r = 0; r < 16; ++r) { p0[r] -= dl; p1[r] -= dl; }
            l_reg *= __builtin_amdgcn_exp2f(-dl); }
        float s0 = 0.f, s1 = 0.f;
        _Pragma("unroll") for (int r = 0; r < 16; ++r) { s0 += __builtin_amdgcn_exp2f(p0[r]); s1 += __builtin_amdgcn_exp2f(p1[r]); }
        l_reg += s0 + s1;
    });
    { auto rr = __builtin_amdgcn_permlane32_swap(__float_as_uint(l_reg), __float_as_uint(l_reg), false, false); l_reg = __uint_as_float(rr[0]) + __uint_as_float(rr[1]); }
    const float ref2 = l_reg > 0.f ? mhat + __builtin_amdgcn_logf(l_reg) : 0.f;
    o[0] = f32x16{}; o[1] = f32x16{};
    float carry = 0.f;
    NSA_LOOP(0, NTc, {
        f32x16 p0, p1; NSA_FILL(b31 - ref2);
        qkt_acc(p0, p1, kp0 + sl * SLOTB, qr);
        if (tile >= cnear) fix_tile<0>(p0, p1, 64 * tile, t, btl, hi);
        _Pragma("unroll") for (int r = 0; r < 16; ++r) { p0[r] = __builtin_amdgcn_exp2f(p0[r]); p1[r] = __builtin_amdgcn_exp2f(p1[r]); }
        { float e_lo[2][4], e_hi[2][4], sg[2][4];
          _Pragma("unroll") for (int hf = 0; hf < 2; ++hf) _Pragma("unroll") for (int q = 0; q < 4; ++q) {
              const f32x16& pp = hf ? p1 : p0; const float x = pp[4 * q + 3];
              auto rr = __builtin_amdgcn_permlane32_swap(__float_as_uint(x), __float_as_uint(x), false, false);
              e_hi[hf][q] = __uint_as_float(rr[0]);
              e_lo[hf][q] = __uint_as_float(rr[1]);
              sg[hf][q] = (pp[4 * q] + pp[4 * q + 1]) + (pp[4 * q + 2] + pp[4 * q + 3]); }
          _Pragma("unroll") for (int hf = 0; hf < 2; ++hf) _Pragma("unroll") for (int q = 0; q < 4; ++q) {
              const float prev_lo = (q > 0) ? e_lo[hf][q - 1] : (hf ? e_lo[0][3] : carry);
              float v = sg[hf][q] + (hi ? e_hi[hf][q] : prev_lo);
              v += __shfl_xor(v, 8); v += __shfl_xor(v, 16);
              if (r32 < 8) imp[(wid * 8 + r32) * 256 + 16 * tile + 8 * hf + 2 * q + hi] = v; }
          carry = e_lo[1][3]; }
        { u32x4 pw0 = {cvtpk(p0[0], p0[1]), cvtpk(p0[2], p0[3]), cvtpk(p0[4], p0[5]), cvtpk(p0[6], p0[7])};
          u32x4 pw1 = {cvtpk(p0[8], p0[9]), cvtpk(p0[10], p0[11]), cvtpk(p0[12], p0[13]), cvtpk(p0[14], p0[15])};
          u32x4 pw2 = {cvtpk(p1[0], p1[1]), cvtpk(p1[2], p1[3]), cvtpk(p1[4], p1[5]), cvtpk(p1[6], p1[7])};
          u32x4 pw3 = {cvtpk(p1[8], p1[9]), cvtpk(p1[10], p1[11]), cvtpk(p1[12], p1[13]), cvtpk(p1[14], p1[15])};
          FA_SBAR();
          pv(o, vb0 + sl * SLOTB, __builtin_bit_cast(bf16x8, pw0), __builtin_bit_cast(bf16x8, pw1), __builtin_bit_cast(bf16x8, pw2), __builtin_bit_cast(bf16x8, pw3)); }
    });
    {
        unsigned key[8][4];
        const int nforced = tb >= 2 ? 3 : tb + 1; const int KS = 16 - nforced;
#pragma unroll
        for (int tk = 0; tk < 8; ++tk) { const lds_f32* row = imp + (wid * 8 + tk) * 256;
#pragma unroll
            for (int k = 0; k < 4; ++k) { const int j = lane + 64 * k; const float v = (j < 16 * NTc) ? row[j] : 0.f;
                const bool cand = (j <= tb) && (j != 0) && (j != tb) && (j != tb - 1);
                key[tk][k] = cand ? __float_as_uint(v) + 1u : 0u; } }
        unsigned T[8];
#pragma unroll
        for (int tk = 0; tk < 8; ++tk) T[tk] = 0u;
        for (int bit = 30; bit >= 0; --bit) {
#pragma unroll
            for (int tk = 0; tk < 8; ++tk) { const unsigned tt = T[tk] | (1u << bit);
                const int c = __popcll(__ballot(key[tk][0] >= tt)) + __popcll(__ballot(key[tk][1] >= tt)) + __popcll(__ballot(key[tk][2] >= tt)) + __popcll(__ballot(key[tk][3] >= tt));
                if (c >= KS) T[tk] = tt; }
        }
        unsigned fw[8];
#pragma unroll
        for (int w = 0; w < 8; ++w) { unsigned f = (w == 0) ? 1u : 0u; if (w == (tb >> 5)) f |= 1u << (tb & 31); if (tb >= 1 && w == ((tb - 1) >> 5)) f |= 1u << ((tb - 1) & 31); fw[w] = f; }
#pragma unroll
        for (int tk = 0; tk < 8; ++tk) {
            const unsigned Tt = T[tk];
            int ngt = 0;
#pragma unroll
            for (int k = 0; k < 4; ++k) ngt += __popcll(__ballot(key[tk][k] > Tt));
            const int rem = KS - ngt; int base = 0;
            unsigned long long sm[4];
#pragma unroll
            for (int k = 0; k < 4; ++k) { const bool eqk = (Tt != 0u) && (key[tk][k] == Tt); const unsigned long long eq = __ballot(eqk);
                const int pre = __builtin_amdgcn_mbcnt_hi((unsigned)(eq >> 32), __builtin_amdgcn_mbcnt_lo((unsigned)eq, 0u));
                sm[k] = __ballot(key[tk][k] > Tt || (eqk && base + pre < rem)); base += __popcll(eq); }
            if (lane == 0) {
#pragma unroll
                for (int k = 0; k < 4; ++k) { selm[(wid * 8 + tk) * 8 + 2 * k] = (unsigned)sm[k] | fw[2 * k]; selm[(wid * 8 + tk) * 8 + 2 * k + 1] = (unsigned)(sm[k] >> 32) | fw[2 * k + 1]; } }
        }
    }
    asm volatile("s_waitcnt lgkmcnt(0)" ::: "memory");
    NSA_ACC(g0, true);
    NSA_SRC(A.KV6 + 2 * A.kvs + (size_t)b * SEQ * 256 + g * 64, A.KV6 + 3 * A.kvs + (size_t)b * SEQ * 256 + g * 64, 256);
    mhat = 0.f; l_reg = 0.f; o[0] = f32x16{}; o[1] = f32x16{};
    NSA_LOOP(0, tb + 1, {
        const unsigned mwv = selm[tokl * 8 + (tile >> 5)]; const bool selb = (mwv >> (tile & 31)) & 1u;
        if (__any(selb)) {
            f32x16 p0, p1; NSA_FILL(selb ? b31 - mhat : -INFINITY);
            qkt_acc(p0, p1, kp0 + sl * SLOTB, qr);
            if (tile + 2 >= tb) fix_tile<1>(p0, p1, 64 * tile, t, btl, hi);
            bool moved; softmax_pv<THRL>(p0, p1, o, mhat, l_reg, moved, wsf, vb0 + sl * SLOTB, r32, hi);
        }
    });
    { auto rr = __builtin_amdgcn_permlane32_swap(__float_as_uint(l_reg), __float_as_uint(l_reg), false, false); l_reg = __uint_as_float(rr[0]) + __uint_as_float(rr[1]); }
    NSA_ACC(l_reg > 0.f ? g1 / l_reg : 0.f, false);
    NSA_SRC(A.KV6 + 4 * A.kvs + (size_t)b * SEQ * 256 + g * 64, A.KV6 + 5 * A.kvs + (size_t)b * SEQ * 256 + g * 64, 256);
    mhat = 0.f; l_reg = 0.f; o[0] = f32x16{}; o[1] = f32x16{};
    NSA_LOOP((tb >= 8 ? tb - 8 : 0), tb + 1, {
        f32x16 p0, p1; NSA_FILL(b31 - mhat);
        qkt_acc(p0, p1, kp0 + sl * SLOTB, qr);
        if (tile + 2 >= tb || tile + 8 == tb) fix_tile<2>(p0, p1, 64 * tile, t, btl, hi);
        bool moved; softmax_pv<THRL>(p0, p1, o, mhat, l_reg, moved, wsf, vb0 + sl * SLOTB, r32, hi);
    });
    { auto rr = __builtin_amdgcn_permlane32_swap(__float_as_uint(l_reg), __float_as_uint(l_reg), false, false); l_reg = __uint_as_float(rr[0]) + __uint_as_float(rr[1]); }
    NSA_ACC(l_reg > 0.f ? g2 / l_reg : 0.f, false);
#pragma unroll
    for (int i = 0; i < 4; ++i) { const int row = i * 8 + (lane >> 3), ch = lane & 7;
        const f32x4 v0 = *(const __attribute__((address_space(3))) f32x4*)(accl + row * 64 + ch * 8), v1 = *(const __attribute__((address_space(3))) f32x4*)(accl + row * 64 + ch * 8 + 4);
        u32x4 w; w.x = cvtpk(v0[0], v0[1]); w.y = cvtpk(v0[2], v0[3]); w.z = cvtpk(v1[0], v1[1]); w.w = cvtpk(v1[2], v1[3]);
        bf16* dst = A.O + ((long)b * SEQ + t0 + wid * 8 + (row & 7)) * DM + (4 * g + (row >> 3)) * HD + ch * 8; *(u32x4*)dst = w; }
    asm volatile("s_waitcnt lgkmcnt(0)\n\ts_barrier" ::: "memory");
#undef NSA_SRC
#undef NSA_DMA
#undef NSA_LOOP
#undef NSA_FILL
#undef NSA_ACC
}
__device__ __forceinline__ void nsa_phase(const Ctx& C, const NsaArgs& A) {
    for (int u = C.vcu; u < 2048; u += C.G) {
        const int v = u & 255, i = u >> 8, bg = v >> 5, s = v & 31; const int base = (i >> 1) * 64; const int tb = (i & 1) ? base + 63 - s : base + s;
        nsa_unit<8>(bg >> 2, bg & 3, tb, A, (char*)C.lds);
    }
}
}

namespace fa {
__device__ __forceinline__ void compress_phase(const Ctx& C, const bf16* KV6, size_t kvs, const bf16* W1T, const bf16* W2T, const float* cb1, bf16* kcmp, bf16* vcmp) {
    int tid = threadIdx.x; asm volatile("" : "+v"(tid));
    const int lane = tid & 63, r32 = lane & 31, hi = lane >> 5; const int wid = __builtin_amdgcn_readfirstlane(tid >> 6);
    const int gw = C.vcu * NWAVES + wid, NGW = C.G * NWAVES;
    for (int u = gw; u < 2 * BATCH * NGRP * 32; u += NGW) {
        const int nb = u & 31, g = (u >> 5) & 3, b = (u >> 7) & 1, kv = u >> 8;
        const int n0 = nb * 32;
        const bf16* X = KV6 + (size_t)kv * kvs + (size_t)b * SEQ * 256 + g * 64;
        const bf16* w1 = W1T + (size_t)kv * 128 * 2048; const bf16* w2 = W2T + (size_t)kv * 64 * 128;
        f32x16 acc[4];
#pragma unroll
        for (int ct = 0; ct < 4; ++ct)
#pragma unroll
            for (int r = 0; r < 16; ++r) acc[ct][r] = cb1[kv * 128 + 32 * ct + crow(r, hi)];
        int tokb = 16 * (n0 + r32); if (tokb > SEQ - 32) tokb = SEQ - 32;
        const bf16* xrow = X + (size_t)tokb * 256 + 8 * hi;
        const bf16* wrow = w1 + (size_t)r32 * 2048 + 8 * hi;
        for (int p = 0; p < 32; ++p) {
#pragma unroll
            for (int ks = 0; ks < 4; ++ks) {
                const bf16x8 bfrag = *reinterpret_cast<const bf16x8*>(xrow + (size_t)p * 256 + 16 * ks);
#pragma unroll
                for (int ct = 0; ct < 4; ++ct) { const bf16x8 afrag = *reinterpret_cast<const bf16x8*>(wrow + (size_t)(32 * ct) * 2048 + p * 64 + 16 * ks);
                    acc[ct] = FA_MFMA(afrag, bfrag, acc[ct]); }
            }
        }
        f32x16 oo[2]; oo[0] = f32x16{}; oo[1] = f32x16{};
#pragma unroll
        for (int ct = 0; ct < 4; ++ct) {
#pragma unroll
            for (int r = 0; r < 16; ++r) { const float a = acc[ct][r]; acc[ct][r] = a / (1.f + __expf(-a)); }
#pragma unroll
            for (int s = 0; s < 2; ++s) {
                u32x4 hb = {cvtpk(acc[ct][8 * s], acc[ct][8 * s + 1]), cvtpk(acc[ct][8 * s + 2], acc[ct][8 * s + 3]), cvtpk(acc[ct][8 * s + 4], acc[ct][8 * s + 5]), cvtpk(acc[ct][8 * s + 6], acc[ct][8 * s + 7])};
#pragma unroll
                for (int dt = 0; dt < 2; ++dt) { const bf16* wp = w2 + (size_t)(32 * dt + r32) * 128 + 32 * ct + 16 * s + 4 * hi;
                    const unsigned long long lo = *reinterpret_cast<const unsigned long long*>(wp), hi8 = *reinterpret_cast<const unsigned long long*>(wp + 8);
                    u32x4 af = {(unsigned)lo, (unsigned)(lo >> 32), (unsigned)hi8, (unsigned)(hi8 >> 32)};
                    oo[dt] = FA_MFMA(__builtin_bit_cast(bf16x8, af), __builtin_bit_cast(bf16x8, hb), oo[dt]); }
            }
        }
        bf16* dst = (kv ? vcmp : kcmp) + (size_t)((b * NGRP + g) * NCMPP + n0 + r32) * 64;
        const bool live = (n0 + r32) < NCMP;
#pragma unroll
        for (int dt = 0; dt < 2; ++dt)
#pragma unroll
            for (int q = 0; q < 4; ++q) { unsigned long long w = (unsigned long long)cvtpk(oo[dt][4 * q], oo[dt][4 * q + 1]) | ((unsigned long long)cvtpk(oo[dt][4 * q + 2], oo[dt][4 * q + 3]) << 32);
                if (!live) w = 0ull; *reinterpret_cast<unsigned long long*>(dst + 32 * dt + 8 * q + 4 * hi) = w; }
    }
}
}
__device__ __forceinline__ bool refresh(Ctx& C) { int t = threadIdx.x; asm volatile("" : "+v"(t)); C.tid = t; C.lane = t & 63; C.wave = __builtin_amdgcn_readfirstlane(t >> 6); return true; }
struct Args { const float* in[18]; float* out; unsigned char* ws; int ph_lo, ph_hi; };
__global__ void __launch_bounds__(NTHREADS, 2) fwd_kernel(Args args) {
    extern __shared__ __attribute__((aligned(16))) unsigned char lds[];
    Ctx C; C.tid = threadIdx.x; C.lane = C.tid & 63; C.wave = __builtin_amdgcn_readfirstlane(C.tid >> 6); C.G = gridDim.x; C.lds = lds;
    { const int bx = blockIdx.x; C.vcu = (C.G % 8 == 0) ? (bx % 8) * (C.G / 8) + bx / 8 : bx; }
    unsigned char* ws = args.ws; const float* const* in = args.in;
    gu32* ctl = (gu32*)(ws + WS_CTL);
    LAS unsigned char* ldsl = (LAS unsigned char*)lds;
    volatile LAS unsigned* MISC = (volatile LAS unsigned*)(ldsl + MISC_OFF);
    for (int u = C.tid; u < (LDS_BYTES - LDSCTL_OFF) / 4; u += NTHREADS) ((LAS unsigned*)(ldsl + LDSCTL_OFF))[u] = 0u;
    __syncthreads();
    const int lo = args.ph_lo, hi = args.ph_hi;
    XcdBarrier bar; bar.bar = (unsigned*)(ctl + CW_BAR); bar.x = 0; bar.st = nullptr;
    if (hi - lo > 1) bar = xcd_barrier_post((unsigned*)(ctl + CW_BAR), MISC + 8);
#define IN(k) (lo <= (k) && (k) < hi && refresh(C))
#define SEAM(k) do { if (lo <= (k) && (k) + 1 < hi) xcd_barrier(bar); } while (0)
    bf16* Wfoxin = (bf16*)(ws + WS_WFOXIN); bf16* Wfoxout = (bf16*)(ws + WS_WFOXOUT); bf16* Wnsain = (bf16*)(ws + WS_WNSAIN); bf16* Wnsaout = (bf16*)(ws + WS_WNSAOUT);
    float* mod = (float*)(ws + WS_MOD); float* cb1 = (float*)(ws + WS_CB1); float* flogit = (float*)(ws + WS_FLOGIT); float* Gf = (float*)(ws + WS_G); float* gates = (float*)(ws + WS_GATES);
    bf16* kcmp = (bf16*)(ws + WS_KCMP); bf16* vcmp = (bf16*)(ws + WS_VCMP); unsigned* SEL = (unsigned*)(ws + WS_SEL);
    bf16* HB = (bf16*)(ws + WS_HBUF); bf16* QO = (bf16*)(ws + WS_R); bf16* KB = (bf16*)(ws + WS_R + 64 * MiB); bf16* VB = (bf16*)(ws + WS_R + 128 * MiB);
    bf16* KV6 = (bf16*)(ws + WS_R + 64 * MiB); const size_t KVS = (size_t)(16 * MiB) / 2;
    bf16* UB = (bf16*)(ws + WS_R); float* OC = (float*)(ws + WS_OC); bf16* KXB = (bf16*)(ws + WS_KX);
    float* XZ = args.out;
    const float* x_in = in[0];

    if (IN(0)) { p_prep(C, in, ws); } SEAM(0);
    if (IN(1)) { p_modrows(C, x_in, mod, 0, DM, HB); } SEAM(1);
    if (IN(2)) { pg8::Gemm g{HB, Wfoxin, TOK, FOXNP, DM}; pg8::StaticOrder S; S.init(TOK, FOXNP, C.G, (int)blockIdx.x);
        pg8::EpiFoxIn E{QO, (size_t)(64 * MiB) / 2, flogit};
        pg8::gemm_phase<pg8::EpiFoxIn, pg8::StaticOrder, true, true>(ldsl, g, S, E); } SEAM(2);
    if (IN(3)) { p_scan(C, flogit, in[7], Gf, KXB, QO, KB, (unsigned*)(ctl + CW_NRM)); } SEAM(3);
    if (IN(4)) { fa::fox_phase(C, QO, KB, VB, KXB, Gf, QO, (const unsigned*)(ctl + CW_NRM), (unsigned*)(ctl + CW_QCTR), MISC + 16); } SEAM(4);
    if (IN(5)) { pg8::Gemm g{QO, Wfoxout, TOK, DM, DM}; pg8::StaticOrder S; S.init(TOK, DM, C.G, (int)blockIdx.x);
        pg8::EpiResid E{x_in, XZ, mod + 2 * DM, 6 * DM, SEQ, DN_ALPHA};
        pg8::gemm_phase<pg8::EpiResid, pg8::StaticOrder, true, true>(ldsl, g, S, E); } SEAM(5);
    if (IN(6)) { p_lnrows(C, XZ, in[4] + 0 * DM, in[5] + 0 * DM, mod, 3 * DM, 4 * DM, HB); } SEAM(6);
    if (IN(7)) { pg8::Gemm g{HB, (bf16*)(ws + WS_WFFIN0), TOK, 2 * FF, DM}; pg8::StaticOrder S; S.init(TOK, 2 * FF, C.G, (int)blockIdx.x);
        pg8::EpiSwiGLU E{UB, FF};
        pg8::gemm_phase<pg8::EpiSwiGLU, pg8::StaticOrder, true, true>(ldsl, g, S, E); } SEAM(7);
    if (IN(8)) { pg8::Gemm g{UB, (bf16*)(ws + WS_WFFOUT0), TOK, DM, FF}; pg8::StaticOrder S; S.init(TOK, DM, C.G, (int)blockIdx.x);
        pg8::EpiResid E{XZ, XZ, mod + 5 * DM, 6 * DM, SEQ, DN_ALPHA};
        pg8::gemm_phase<pg8::EpiResid, pg8::StaticOrder, true, true>(ldsl, g, S, E); } SEAM(8);
    const float* mod1 = mod + BATCH * 6 * DM;
    if (IN(9)) { p_lnrows(C, XZ, in[4] + 1 * DM, in[5] + 1 * DM, mod1, 0, DM, HB); } SEAM(9);
    if (IN(10)) { pg8::Gemm g{HB, Wnsain, TOK, NSANP, DM}; pg8::StaticOrder S; S.init(TOK, NSANP, C.G, (int)blockIdx.x);
        pg8::EpiNsaIn E{QO, KV6, KVS, gates, in[10]};
        pg8::gemm_phase<pg8::EpiNsaIn, pg8::StaticOrder, true, true>(ldsl, g, S, E); } SEAM(10);
    if (IN(11)) { fa::compress_phase(C, KV6, KVS, (const bf16*)(ws + WS_W1T), (const bf16*)(ws + WS_W2T), cb1, kcmp, vcmp); } SEAM(11);
    if (IN(12)) { fa::NsaArgs NA{QO, KV6, KVS, kcmp, vcmp, in[15], gates, QO}; fa::nsa_phase(C, NA); } SEAM(12);
    if (IN(13)) { } SEAM(13);
    if (IN(14)) { pg8::Gemm g{QO, Wnsaout, TOK, DM, DM}; pg8::StaticOrder S; S.init(TOK, DM, C.G, (int)blockIdx.x);
        pg8::EpiResid E{XZ, XZ, mod1 + 2 * DM, 6 * DM, SEQ, DN_ALPHA};
        pg8::gemm_phase<pg8::EpiResid, pg8::StaticOrder, true, true>(ldsl, g, S, E); } SEAM(14);
    if (IN(15)) { p_lnrows(C, XZ, in[4] + 2 * DM, in[5] + 2 * DM, mod1, 3 * DM, 4 * DM, HB); } SEAM(15);
    if (IN(16)) { pg8::Gemm g{HB, (bf16*)(ws + WS_WFFIN1), TOK, 2 * FF, DM}; pg8::StaticOrder S; S.init(TOK, 2 * FF, C.G, (int)blockIdx.x);
        pg8::EpiSwiGLU E{UB, FF};
        pg8::gemm_phase<pg8::EpiSwiGLU, pg8::StaticOrder, true, true>(ldsl, g, S, E); } SEAM(16);
    if (IN(17)) { pg8::Gemm g{UB, (bf16*)(ws + WS_WFFOUT1), TOK, DM, FF}; pg8::StaticOrder S; S.init(TOK, DM, C.G, (int)blockIdx.x);
        pg8::EpiResid E{XZ, XZ, mod1 + 5 * DM, 6 * DM, SEQ, DN_ALPHA};
        pg8::gemm_phase<pg8::EpiResid, pg8::StaticOrder, true, true>(ldsl, g, S, E); } SEAM(17);
    if (IN(18)) { p_lnrows(C, XZ, in[4] + 3 * DM, in[5] + 3 * DM, mod1, 0, 0, nullptr); }
#undef IN
#undef SEAM
}

extern "C" void kernel_launch(void* const* d_in, const int* in_sizes, int n_in, void* d_out, int out_size, void* d_ws, size_t ws_size, hipStream_t stream) {
    static int grid = 0;
    if (grid == 0) {
        if (n_in != 18 || in_sizes[0] != TOK * DM || out_size != TOK * DM || ws_size < WS_END) { fprintf(stderr, "kernel_launch: unexpected shapes (n_in %d, in0 %d, out %d, ws %zu)\n", n_in, n_in > 0 ? in_sizes[0] : -1, out_size, ws_size); grid = -1; return; }
        int dev = 0, cus = 0, per_cu = 0;
        if (hipGetDevice(&dev) != hipSuccess || hipDeviceGetAttribute(&cus, hipDeviceAttributeMultiprocessorCount, dev) != hipSuccess) { grid = -1; return; }
        if (hipFuncSetAttribute((const void*)fwd_kernel, hipFuncAttributeMaxDynamicSharedMemorySize, LDS_BYTES) != hipSuccess) { fprintf(stderr, "kernel_launch: hipFuncSetAttribute failed\n"); grid = -1; return; }
        if (hipOccupancyMaxActiveBlocksPerMultiprocessor(&per_cu, (const void*)fwd_kernel, NTHREADS, LDS_BYTES) != hipSuccess || per_cu < 1) fprintf(stderr, "kernel_launch: occupancy query reports %d\n", per_cu);
        (void)hipGetLastError();
        grid = cus;
        if (grid != 256) fprintf(stderr, "kernel_launch: note: %d CUs\n", grid);
    }
    if (grid < 0) return;
    (void)hipMemsetAsync((char*)d_ws + WS_CTL, 0, CTL_ZERO_BYTES, stream);
    Args a{};
    for (int i = 0; i < 18; ++i) a.in[i] = (const float*)d_in[i];
    a.out = (float*)d_out; a.ws = (unsigned char*)d_ws;
#if MK_PER_PHASE
    for (int p = 0; p < N_PHASES; ++p) { a.ph_lo = p; a.ph_hi = p + 1; hipLaunchKernelGGL(fwd_kernel, dim3(grid), dim3(NTHREADS), LDS_BYTES, stream, a); }
#else
    a.ph_lo = 0; a.ph_hi = N_PHASES;
    hipLaunchKernelGGL(fwd_kernel, dim3(grid), dim3(NTHREADS), LDS_BYTES, stream, a);
#endif
}
```
